# Optimizing an MI355X kernel written in HIP

```python
import math
import jax
import jax.numpy as jnp
from jax import lax
import numpy as np

D_MODEL = 1024
BATCH = 32
SEQ = 256
DEPTH = 4
DEC_BATCH = 2
DEC_SEQ = 2048
PAST_LEN = 512

GRID_W = 64
ROPE_THETA = 10000.0
Q_BLOCK = 128
EPS = 1e-6
N_BRANCH = 4
BRANCH_W = D_MODEL // 4
FNET_GROUPS = 4
FNET_GW = BRANCH_W // FNET_GROUPS
GQA_HEADS = 4
GQA_KV_HEADS = 2
GQA_HEAD_DIM = BRANCH_W // GQA_HEADS
DIFF_HEADS = 4
DIFF_V_DIM = BRANCH_W // DIFF_HEADS
DIFF_QK_DIM = DIFF_V_DIM // 2
SGU_GROUPS = 4
SGU_CHUNK = 128
SGU_GW = BRANCH_W // SGU_GROUPS
D_FF = 4 * D_MODEL
N_MOD = 6

_IN_SPLITS = (
    BRANCH_W,
    GQA_HEADS * GQA_HEAD_DIM,
    GQA_KV_HEADS * GQA_HEAD_DIM,
    GQA_KV_HEADS * GQA_HEAD_DIM,
    DIFF_HEADS * 2 * DIFF_QK_DIM,
    DIFF_HEADS * 2 * DIFF_QK_DIM,
    DIFF_HEADS * DIFF_V_DIM,
    BRANCH_W,
    BRANCH_W,
)
IN_W = sum(_IN_SPLITS)

kernel_name = "hybrid_diffusion_prefix_trunk_step"


def _rms_norm(x, g):
    xf = x.astype(jnp.float32)
    y = xf * lax.rsqrt(jnp.mean(xf * xf, axis=-1, keepdims=True) + EPS)
    return (y * g.astype(jnp.float32)).astype(x.dtype)


def _split_cols(proj):
    idx = []
    acc = 0
    for s in _IN_SPLITS[:-1]:
        acc += s
        idx.append(acc)
    return jnp.split(proj, idx, axis=-1)


def _axial_rope(length, dim):
    rows = length // GRID_W
    row = jnp.repeat(jnp.arange(rows, dtype=jnp.float32), GRID_W)
    col = jnp.tile(jnp.arange(GRID_W, dtype=jnp.float32), rows)
    quarter = dim // 4
    inv = ROPE_THETA ** (-jnp.arange(quarter, dtype=jnp.float32) / quarter)
    ang = jnp.concatenate([row[:, None] * inv, col[:, None] * inv], axis=-1)
    return jnp.cos(ang), jnp.sin(ang)


def _apply_rope(x, cos, sin):
    half = x.shape[-1] // 2
    shape = (1, x.shape[1]) + (1,) * (x.ndim - 3) + (half,)
    c = cos.reshape(shape)
    s = sin.reshape(shape)
    xf = x.astype(jnp.float32)
    x1, x2 = xf[..., :half], xf[..., half:]
    return jnp.concatenate([x1 * c - x2 * s, x1 * s + x2 * c], axis=-1).astype(x.dtype)


def _gqa_attention(q, k, v):
    b, sq, h, dh = q.shape
    hkv = k.shape[2]
    g = h // hkv
    nb = sq // Q_BLOCK
    scale = 1.0 / math.sqrt(dh)
    qb = q.reshape(b, nb, Q_BLOCK, hkv, g, dh).transpose(1, 0, 2, 3, 4, 5)

    def one_block(qblk):
        s = jnp.einsum("bqkgd,bskd->bkgqs", qblk, k, preferred_element_type=jnp.float32) * scale
        p = jax.nn.softmax(s, axis=-1).astype(v.dtype)
        return jnp.einsum("bkgqs,bskd->bqkgd", p, v)

    o = lax.map(one_block, qb)
    return o.transpose(1, 0, 2, 3, 4, 5).reshape(b, sq, h * dh)


def _diff_attention(q, k, v, lam):
    b, sq, h, _, dq = q.shape
    nb = sq // Q_BLOCK
    scale = 1.0 / math.sqrt(dq)
    qb = q.reshape(b, nb, Q_BLOCK, h, 2, dq).transpose(1, 0, 2, 3, 4, 5)

    def one_block(qblk):
        s = jnp.einsum("bqhmd,bshmd->bhmqs", qblk, k, preferred_element_type=jnp.float32) * scale
        p = jax.nn.softmax(s, axis=-1)
        w = (p[:, :, 0] - lam * p[:, :, 1]).astype(v.dtype)
        return jnp.einsum("bhqs,bshd->bqhd", w, v)

    o = lax.map(one_block, qb)
    return o.transpose(1, 0, 2, 3, 4).reshape(b, sq, h, v.shape[-1])


def _mixer(h, lp, lam, lam_scale, ctx):
    b, length, _ = h.shape
    a, bq, bk, bv, cq, ck, cv, du, dv = _split_cols(h @ lp["w_in"])

    af = a.reshape(b, length, FNET_GROUPS, FNET_GW).astype(jnp.float32)
    af = jnp.fft.fft2(af, axes=(1, 3), norm="ortho").real
    out_a = af.astype(h.dtype).reshape(b, length, BRANCH_W) @ lp["w_fourier"]

    bq = _rms_norm(bq.reshape(b, length, GQA_HEADS, GQA_HEAD_DIM), lp["q_norm_g"])
    bk = _rms_norm(bk.reshape(b, length, GQA_KV_HEADS, GQA_HEAD_DIM), lp["k_norm_g"])
    bv = bv.reshape(b, length, GQA_KV_HEADS, GQA_HEAD_DIM)
    cq = cq.reshape(b, length, DIFF_HEADS, 2, DIFF_QK_DIM)
    ck = ck.reshape(b, length, DIFF_HEADS, 2, DIFF_QK_DIM)
    cv = cv.reshape(b, length, DIFF_HEADS, DIFF_V_DIM)

    if ctx is None:
        new_kv = (bk, bv, ck, cv)
        kb, vb, kc, vc = bk, bv, ck, cv
    else:
        new_kv = None
        cos_b, sin_b = _axial_rope(length, GQA_HEAD_DIM)
        cos_c, sin_c = _axial_rope(length, DIFF_QK_DIM)
        bq = _apply_rope(bq, cos_b, sin_b)
        bk = _apply_rope(bk, cos_b, sin_b)
        cq = _apply_rope(cq, cos_c, sin_c)
        ck = _apply_rope(ck, cos_c, sin_c)
        ctx_bk, ctx_bv, ctx_ck, ctx_cv = ctx
        kb = jnp.concatenate([ctx_bk, bk], axis=1)
        vb = jnp.concatenate([ctx_bv, bv], axis=1)
        kc = jnp.concatenate([ctx_ck, ck], axis=1)
        vc = jnp.concatenate([ctx_cv, cv], axis=1)

    out_b = _gqa_attention(bq, kb, vb)
    oc = _diff_attention(cq, kc, vc, lam)
    out_c = (_rms_norm(oc, lp["diff_norm_g"]) * lam_scale).reshape(b, length, BRANCH_W)

    du = jax.nn.gelu(du)
    dv = _rms_norm(jax.nn.gelu(dv), lp["sgu_norm_g"])
    dv = dv.reshape(b, length // SGU_CHUNK, SGU_CHUNK, SGU_GROUPS, SGU_GW)
    s = jnp.einsum("gqp,bnpgc->bnqgc", lp["w_spatial"], dv) + lp["b_spatial"].T[None, None, :, :, None]
    out_d = du * s.reshape(b, length, BRANCH_W)

    branches = jnp.stack([out_a, out_b, out_c, out_d], axis=2)
    bproj = jnp.einsum("blnc,ncd->blnd", branches, lp["w_branch"])
    gates = jax.nn.sigmoid(h @ lp["w_gate"]).reshape(b, length, N_BRANCH, D_MODEL)
    merged = jnp.sum(gates * bproj, axis=2)
    return merged @ lp["w_out"], new_kv


def _block(x, cond, lp, lam, lam_scale, ctx):
    mod = (jax.nn.silu(cond) @ lp["w_ada"] + lp["b_ada"])[:, None, :]
    sh1, sc1, g1, sh2, sc2, g2 = jnp.split(mod, N_MOD, axis=-1)
    h = _rms_norm(x, lp["norm1_g"]) * (1 + sc1) + sh1
    m, new_kv = _mixer(h, lp, lam, lam_scale, ctx)
    x = x + g1 * m
    h = _rms_norm(x, lp["norm2_g"]) * (1 + sc2) + sh2
    f = jnp.square(jax.nn.relu(h @ lp["w_mlp1"])) @ lp["w_mlp2"]
    return x + g2 * f, new_kv


def setup_inputs(seed: int = 0) -> dict:
    key = jax.random.key(seed)
    ks = jax.random.split(key, 32)
    f32 = jnp.float32

    def nrm(k, shape, scale):
        return jax.random.normal(k, shape, f32) * scale

    def gain(k, shape):
        return 1.0 + 0.01 * jax.random.normal(k, shape, f32)

    return {
        "x_prompt": nrm(ks[0], (BATCH, SEQ, D_MODEL), 1.0),
        "x_sample": nrm(ks[1], (DEC_BATCH, DEC_SEQ, D_MODEL), 1.0),
        "c": nrm(ks[2], (DEC_BATCH, D_MODEL), 1.0),
        "cache_gqa_k": nrm(ks[3], (DEC_BATCH, DEPTH, PAST_LEN, GQA_KV_HEADS, GQA_HEAD_DIM), 1.0),
        "cache_gqa_v": nrm(ks[4], (DEC_BATCH, DEPTH, PAST_LEN, GQA_KV_HEADS, GQA_HEAD_DIM), 1.0),
        "cache_diff_k": nrm(ks[5], (DEC_BATCH, DEPTH, PAST_LEN, DIFF_HEADS, 2, DIFF_QK_DIM), 1.0),
        "cache_diff_v": nrm(ks[6], (DEC_BATCH, DEPTH, PAST_LEN, DIFF_HEADS, DIFF_V_DIM), 1.0),
        "c_ctx": nrm(ks[7], (D_MODEL,), 1.0),
        "w_ada": nrm(ks[8], (DEPTH, D_MODEL, N_MOD * D_MODEL), 0.5 * D_MODEL ** -0.5),
        "b_ada": nrm(ks[9], (DEPTH, N_MOD * D_MODEL), 0.01),
        "norm1_g": gain(ks[10], (DEPTH, D_MODEL)),
        "norm2_g": gain(ks[11], (DEPTH, D_MODEL)),
        "w_in": nrm(ks[12], (DEPTH, D_MODEL, IN_W), D_MODEL ** -0.5),
        "w_fourier": nrm(ks[13], (DEPTH, BRANCH_W, BRANCH_W), BRANCH_W ** -0.5),
        "q_norm_g": gain(ks[14], (DEPTH, GQA_HEAD_DIM)),
        "k_norm_g": gain(ks[15], (DEPTH, GQA_HEAD_DIM)),
        "lambda_q1": nrm(ks[16], (DEPTH, DIFF_QK_DIM), 0.1),
        "lambda_k1": nrm(ks[17], (DEPTH, DIFF_QK_DIM), 0.1),
        "lambda_q2": nrm(ks[18], (DEPTH, DIFF_QK_DIM), 0.1),
        "lambda_k2": nrm(ks[19], (DEPTH, DIFF_QK_DIM), 0.1),
        "diff_norm_g": gain(ks[20], (DEPTH, DIFF_V_DIM)),
        "sgu_norm_g": gain(ks[21], (DEPTH, BRANCH_W)),
        "w_spatial": nrm(ks[22], (DEPTH, SGU_GROUPS, SGU_CHUNK, SGU_CHUNK), SGU_CHUNK ** -0.5),
        "b_spatial": nrm(ks[23], (DEPTH, SGU_GROUPS, SGU_CHUNK), 0.01),
        "w_gate": nrm(ks[24], (DEPTH, D_MODEL, N_BRANCH * D_MODEL), D_MODEL ** -0.5),
        "w_branch": nrm(ks[25], (DEPTH, N_BRANCH, BRANCH_W, D_MODEL), BRANCH_W ** -0.5),
        "w_out": nrm(ks[26], (DEPTH, D_MODEL, D_MODEL), D_MODEL ** -0.5),
        "w_mlp1": nrm(ks[27], (DEPTH, D_MODEL, D_FF), D_MODEL ** -0.5),
        "w_mlp2": nrm(ks[28], (DEPTH, D_FF, D_MODEL), D_FF ** -0.5),
        "final_norm_g": gain(ks[29], (D_MODEL,)),
    }


def reference(x_prompt, x_sample, c, cache_gqa_k, cache_gqa_v, cache_diff_k, cache_diff_v,
              c_ctx, w_ada, b_ada, norm1_g, norm2_g, w_in, w_fourier, q_norm_g, k_norm_g,
              lambda_q1, lambda_k1, lambda_q2, lambda_k2, diff_norm_g, sgu_norm_g,
              w_spatial, b_spatial, w_gate, w_branch, w_out, w_mlp1, w_mlp2, final_norm_g):
    xp = x_prompt
    xs = x_sample
    cond_ctx = c_ctx[None, :]
    gk, gv, dk, dv = [], [], [], []
    for l in range(DEPTH):
        lp = {
            "w_ada": w_ada[l], "b_ada": b_ada[l], "norm1_g": norm1_g[l], "norm2_g": norm2_g[l],
            "w_in": w_in[l], "w_fourier": w_fourier[l], "q_norm_g": q_norm_g[l],
            "k_norm_g": k_norm_g[l], "diff_norm_g": diff_norm_g[l], "sgu_norm_g": sgu_norm_g[l],
            "w_spatial": w_spatial[l], "b_spatial": b_spatial[l], "w_gate": w_gate[l],
            "w_branch": w_branch[l], "w_out": w_out[l], "w_mlp1": w_mlp1[l], "w_mlp2": w_mlp2[l],
        }
        lam_init = 0.8 - 0.6 * math.exp(-0.3 * l)
        lam = (jnp.exp(jnp.sum(lambda_q1[l].astype(jnp.float32) * lambda_k1[l].astype(jnp.float32)))
               - jnp.exp(jnp.sum(lambda_q2[l].astype(jnp.float32) * lambda_k2[l].astype(jnp.float32)))
               + lam_init)
        lam_scale = 1.0 - lam_init
        xp, (bk, bv, ck, cv) = _block(xp, cond_ctx, lp, lam, lam_scale, None)
        gk.append(bk)
        gv.append(bv)
        dk.append(ck)
        dv.append(cv)
        ctx = (cache_gqa_k[:, l], cache_gqa_v[:, l], cache_diff_k[:, l], cache_diff_v[:, l])
        xs, _ = _block(xs, c, lp, lam, lam_scale, ctx)
    y_prompt = _rms_norm(xp, final_norm_g)
    y_sample = _rms_norm(xs, final_norm_g)
    new_gqa_k = jnp.stack(gk, axis=1)
    new_gqa_v = jnp.stack(gv, axis=1)
    new_diff_k = jnp.stack(dk, axis=1)
    new_diff_v = jnp.stack(dv, axis=1)
    return (y_prompt, y_sample, new_gqa_k, new_gqa_v, new_diff_k, new_diff_v)
```

```cpp
#include <hip/hip_runtime.h>
#include <hip/hip_cooperative_groups.h>
#include <cstdio>
#include <cstdint>
namespace cg = cooperative_groups;

#define LAS __attribute__((address_space(3)))
#define DI __device__ __forceinline__
typedef unsigned short bf16_t;
typedef short bf16x8 __attribute__((ext_vector_type(8)));
typedef short s16x4 __attribute__((ext_vector_type(4)));
typedef float f32x4 __attribute__((ext_vector_type(4)));
typedef float f32x16 __attribute__((ext_vector_type(16)));
typedef unsigned u32x4 __attribute__((ext_vector_type(4)));
typedef unsigned u32x2 __attribute__((ext_vector_type(2)));
typedef __bf16 bf16x2_t __attribute__((ext_vector_type(2)));
typedef float f32x2_t __attribute__((ext_vector_type(2)));

constexpr int T = 12288, TC = 8192, DM = 1024, NPROJ = 1792;
constexpr int NWAVES = 8;
constexpr float EPS = 1e-6f;

constexpr size_t MiB = 1u << 20;
constexpr size_t CTL_BYTES = 1 * MiB;
constexpr size_t CTL_CTR = 0;
constexpr size_t CTL_MOD = 65536;
constexpr size_t CTL_LAM = CTL_MOD + 294912;
constexpr size_t CTL_FLAG = 524288 + 16384;
constexpr size_t CTL_BAR = 524288;
constexpr size_t WS_W = 1 * MiB;
constexpr size_t W_CAT = 0, W_A = W_CAT + 12058624, W_BALL = W_A + 1048576, W_OUT = W_BALL + 2621440, W_1 = W_OUT + 2097152,
                 W_2 = W_1 + 8388608, W_SP = W_2 + 8388608, W_LAYER = W_SP + 262144;
constexpr size_t WS_FCTX = WS_W + 4 * W_LAYER;
constexpr size_t WS_FLAT = WS_FCTX + 262144;
constexpr size_t WS_GATES = WS_FLAT + 16777216;
constexpr size_t WS_H = WS_GATES + 100663296;
constexpr size_t WS_PROJ = WS_H + 25165824;
constexpr size_t WS_S = WS_H;
constexpr size_t WS_BR = WS_PROJ + 44040192;
constexpr size_t WS_ZTC = WS_BR + 31457280;
constexpr size_t WS_ZTL = WS_ZTC + 8388608;
constexpr size_t WS_ATT = WS_ZTL + 4194304;
constexpr size_t A_QB = 0, A_KBC = 6291456, A_KBL = 8388608, A_VBC = 9699328, A_VBL = 11796480, A_QC = 13107200, A_KCC = 19398656,
                 A_KCL = 23592960, A_VCC = 26214400, A_VCL = 30408704, A_END = 33030144;
constexpr size_t WS_MERGED = WS_ATT;
constexpr size_t WS_DVT = WS_ATT + A_END;
constexpr size_t WS_END = WS_DVT + 6291456;
static_assert(WS_S + 50331648 <= WS_BR, "S overlay");
static_assert(25165824 <= A_END, "merged overlay");

constexpr size_t O_GK = 12582912, O_GV = 16777216, O_DK = 20971520, O_DV = 29360128;

struct Params { const float* in[30]; float* out; unsigned char* ws; };

DI unsigned cvtpk(float lo, float hi) { f32x2_t v = {lo, hi}; bf16x2_t b = __builtin_convertvector(v, bf16x2_t); return __builtin_bit_cast(unsigned, b); }
DI float bflo(unsigned u) { return __builtin_bit_cast(float, u << 16); }
DI float bfhi(unsigned u) { return __builtin_bit_cast(float, u & 0xffff0000u); }
DI void unpack8(u32x4 w, float* f) { f[0] = bflo(w.x); f[1] = bfhi(w.x); f[2] = bflo(w.y); f[3] = bfhi(w.y); f[4] = bflo(w.z); f[5] = bfhi(w.z); f[6] = bflo(w.w); f[7] = bfhi(w.w); }
DI u32x4 pack8(const float* f) { u32x4 w; w.x = cvtpk(f[0], f[1]); w.y = cvtpk(f[2], f[3]); w.z = cvtpk(f[4], f[5]); w.w = cvtpk(f[6], f[7]); return w; }
DI float sigmoidf_(float v) { return __builtin_amdgcn_rcpf(1.f + __expf(-v)); }
DI float gelu_tanh(float v) { return v * sigmoidf_(1.5957691216057308f * (v + 0.044715f * v * v * v)); }
DI int fast_tid() {
    const unsigned hw = (unsigned)__builtin_amdgcn_s_getreg((5 << 11) | 4) & 63u;
    const int wv = ((const volatile LAS int*)(131072 + 64))[hw];
    return __builtin_amdgcn_readfirstlane(wv) * 64 + (int)__builtin_amdgcn_mbcnt_hi(~0u, __builtin_amdgcn_mbcnt_lo(~0u, 0u));
}
#define TIDX fast_tid()
DI int opaque_v(int x) { asm volatile("" : "+v"(x)); return x; }
DI float wave_sum(float v) {
#pragma unroll
    for (int o = 1; o < 64; o <<= 1) v += __shfl_xor(v, o);
    return v;
}

namespace pg8 {
constexpr int BM = 256, BK = 64, HALF = 128, HTB = HALF * BK * 2, STAGE_BYTES = 8 * HTB;
DI int lds_byte(int r, int c) { const int st = (r >> 4) * 2 + (c >> 5), rr = r & 15, cc = c & 31, ob = rr * 64 + cc * 2; return st * 1024 + (ob ^ (((ob >> 9) & 1) << 5)); }
DI void stage_rc(int b, int& R, int& C) { const int st = b / 1024, sb = b % 1024, swz = sb ^ (((sb >> 9) & 1) << 5); R = (st >> 1) * 16 + swz / 64; C = (st & 1) * 32 + (swz % 64) / 2; }
DI int perm32(int rho) { const int n = rho >> 4, i = rho & 15; return 8 * (i >> 2) + 4 * n + (i & 3); }

struct Unit { const char* A; const char* B; int nt, r0, c0, z, keep; };

template <class Epi, class Sched>
DI void gemm_phase(LAS unsigned char* lds, const int lda, const int ldb, const Sched& S, const Epi& E) {
    const int tid = opaque_v(TIDX), wid = __builtin_amdgcn_readfirstlane(tid >> 6), lane = tid & 63, wr = wid >> 2, wc = wid & 3, fr = lane & 15, fq = lane >> 4;
    unsigned voffA[2], voffB[2];
#pragma unroll
    for (int i = 0; i < 2; ++i) { int R, C; stage_rc(tid * 16 + i * 8192, R, C); const int Rb = (R & ~31) + perm32(R & 31);
        voffA[i] = (unsigned)(R * lda + C) * 2u; voffB[i] = (unsigned)(Rb * ldb + C) * 2u; }
    const size_t kstep = (size_t)(BK * 2);
    const size_t hstepA = (size_t)HALF * lda * 2, hstepB = (size_t)HALF * ldb * 2;
    const unsigned ldsw = (unsigned)wid * 1024u;
    const int aoff = lds_byte(wr * 64 + fr, fq * 8), boff = lds_byte(wc * 32 + fr, fq * 8);
#define PG8_SA(b, h) (((b) * 2 + (h)) * HTB)
#define PG8_SB(b, h) ((4 + (b) * 2 + (h)) * HTB)
#define PG8_STAGE(bufoff, gbase, voff) do { _Pragma("unroll") for (int _i = 0; _i < 2; ++_i) \
        __builtin_amdgcn_global_load_lds((const unsigned*)((const char*)(gbase) + (voff)[_i]), (LAS unsigned*)(lds + (bufoff) + ldsw + _i * 8192), 16, 0, 0); } while (0)
#define PG8_LDA(dst, b, h) do { _Pragma("unroll") for (int m = 0; m < 4; ++m) _Pragma("unroll") for (int k = 0; k < 2; ++k) dst[m][k] = *(const LAS bf16x8*)(lds + PG8_SA(b, h) + aoff + m * 2048 + k * 1024); } while (0)
#define PG8_LDB(dst, b, h) do { _Pragma("unroll") for (int n = 0; n < 2; ++n) _Pragma("unroll") for (int k = 0; k < 2; ++k) dst[n][k] = *(const LAS bf16x8*)(lds + PG8_SB(b, h) + boff + n * 2048 + k * 1024); } while (0)
#define PG8_MMA(ai, bj, At, Bt) do { __builtin_amdgcn_s_setprio(1); _Pragma("unroll") for (int m = 0; m < 4; ++m) _Pragma("unroll") for (int n = 0; n < 2; ++n) _Pragma("unroll") for (int k = 0; k < 2; ++k) \
        acc[ai][bj][m][n] = __builtin_amdgcn_mfma_f32_16x16x32_bf16(Bt[n][k], At[m][k], acc[ai][bj][m][n], 0, 0, 0); __builtin_amdgcn_s_setprio(0); } while (0)
#define PG8_WAIT_V(n) asm volatile("s_waitcnt vmcnt(" #n ")" ::: "memory")
#define PG8_WAIT_L(n) asm volatile("s_waitcnt lgkmcnt(" #n ")" ::: "memory")
#define PG8_BAR __builtin_amdgcn_s_barrier()
#define PG8_SCHED __builtin_amdgcn_sched_barrier(0)
    Unit cur, nxt; int ui = 0;
    if (!S.next(0, cur)) return;
    f32x4 acc[2][2][4][2];
#pragma unroll
    for (int a = 0; a < 2; ++a)
#pragma unroll
        for (int b = 0; b < 2; ++b)
#pragma unroll
            for (int m = 0; m < 4; ++m)
#pragma unroll
                for (int n = 0; n < 2; ++n) acc[a][b][m][n] = (f32x4){0.f, 0.f, 0.f, 0.f};
    bf16x8 At[4][2], B0[2][2], B1[2][2];
    const char* cA = cur.A; const char* cB = cur.B;
    PG8_STAGE(PG8_SB(0, 0), cB, voffB); PG8_STAGE(PG8_SB(0, 1), cB + hstepB, voffB); PG8_STAGE(PG8_SA(0, 0), cA, voffA); PG8_STAGE(PG8_SA(0, 1), cA + hstepA, voffA);
    if (wr == 1) PG8_BAR;
    PG8_WAIT_V(2); PG8_BAR;
    PG8_STAGE(PG8_SB(1, 0), cB + kstep, voffB); PG8_STAGE(PG8_SA(1, 0), cA + kstep, voffA); PG8_STAGE(PG8_SB(1, 1), cB + hstepB + kstep, voffB);
    PG8_WAIT_V(6); PG8_BAR;
    for (;;) {
        const bool has_next = S.next(ui + 1, nxt);
        const char* nA = has_next ? nxt.A : cA; const char* nB = has_next ? nxt.B : cB;
        const int nt = cur.nt;
        for (int t = 0; t < nt; t += 2) {
            const bool last = (t == nt - 2);
            const char* a1 = cA + (size_t)(t + 1) * kstep;
            const char* a2 = last ? nA : cA + (size_t)(t + 2) * kstep; const char* b2 = last ? nB : cB + (size_t)(t + 2) * kstep;
            const char* a3 = a2 + kstep; const char* b3 = b2 + kstep;
            PG8_LDB(B0, 0, 0); PG8_LDB(B1, 0, 1); PG8_SCHED; PG8_LDA(At, 0, 0); PG8_STAGE(PG8_SA(1, 1), a1 + hstepA, voffA);
            PG8_WAIT_V(8); PG8_WAIT_L(0); PG8_BAR; PG8_MMA(0, 0, At, B0); PG8_MMA(0, 1, At, B1); PG8_BAR; PG8_SCHED;
            PG8_LDA(At, 0, 1); PG8_STAGE(PG8_SB(0, 0), b2, voffB); PG8_STAGE(PG8_SB(0, 1), b2 + hstepB, voffB); PG8_STAGE(PG8_SA(0, 0), a2, voffA);
            PG8_WAIT_V(8); PG8_WAIT_L(0); PG8_BAR; PG8_MMA(1, 0, At, B0); PG8_MMA(1, 1, At, B1); PG8_BAR; PG8_SCHED;
            PG8_LDB(B0, 1, 0); PG8_LDB(B1, 1, 1); PG8_SCHED; PG8_LDA(At, 1, 0); PG8_STAGE(PG8_SA(0, 1), a2 + hstepA, voffA);
            PG8_WAIT_V(8); PG8_WAIT_L(0); PG8_BAR; PG8_MMA(0, 0, At, B0); PG8_MMA(0, 1, At, B1); PG8_BAR; PG8_SCHED;
            PG8_LDA(At, 1, 1); PG8_STAGE(PG8_SB(1, 0), b3, voffB); PG8_STAGE(PG8_SB(1, 1), b3 + hstepB, voffB); PG8_STAGE(PG8_SA(1, 0), a3, voffA);
            PG8_WAIT_V(8); PG8_WAIT_L(0); PG8_BAR; PG8_MMA(1, 0, At, B0); PG8_MMA(1, 1, At, B1); PG8_BAR; PG8_SCHED;
        }
        if (wr == 0) PG8_BAR;
        { const int ln_ = opaque_v(TIDX) & 63, fr_ = ln_ & 15, fq_ = ln_ >> 4;
        E.pre(acc, cur);
        E(acc, cur, wr, wc, fr_, fq_);
        if (!has_next) break;
        E.scale(acc, cur, wr, wc, fr_, fq_); }
        if (!nxt.keep) {
#pragma unroll
        for (int a = 0; a < 2; ++a)
#pragma unroll
            for (int b = 0; b < 2; ++b)
#pragma unroll
                for (int m = 0; m < 4; ++m)
#pragma unroll
                    for (int n = 0; n < 2; ++n) acc[a][b][m][n] = (f32x4){0.f, 0.f, 0.f, 0.f};
        }
        cur = nxt; cA = nA; cB = nB; ++ui;
        if (wr == 1) PG8_BAR;
    }
    PG8_WAIT_V(0);
    PG8_BAR;
#undef PG8_SA
#undef PG8_SB
#undef PG8_STAGE
#undef PG8_LDA
#undef PG8_LDB
#undef PG8_MMA
#undef PG8_WAIT_V
#undef PG8_WAIT_L
#undef PG8_BAR
#undef PG8_SCHED
}
}

enum { J_G1A = 0, J_G1B, J_DFTL, J_DFTC, J_SGU, J_G2, J_G3, J_G4, J_G5 };

DI void xcd_decode(int L, int nM, int nN, int nwg, int& pm, int& pn) {
    int wgid = L; { const int q = nwg / 8, r = nwg % 8, xcd = wgid % 8, off = wgid / 8; wgid = (xcd < r ? xcd * (q + 1) : r * (q + 1) + (xcd - r) * q) + off; }
    const int nig = 8 * nN, gid = wgid / nig, fm = gid * 8, gsz = (nM - fm) < 8 ? (nM - fm) : 8;
    pm = fm + ((wgid % nig) % gsz); pn = (wgid % nig) / gsz;
}

struct Sched {
    int job, G, c;
    const char* A; const char* B; int lda, ldb, nM, nN, nwg, nt;
    DI bool next(int i, pg8::Unit& u) const {
        if (job == J_G2) {
            if (c >= 192 || i >= 4) return false;
            int pm, pn; xcd_decode(c, 48, 4, 192, pm, pn);
            const int koff = i == 0 ? 0 : 256 + 256 * i;
            u.A = A + ((size_t)pm * 256 * 1280 + koff) * 2; u.B = B + ((size_t)pn * 256 * 1280 + koff) * 2; u.nt = i == 0 ? 8 : 4; u.r0 = pm * 256; u.c0 = pn * 256; u.z = i; u.keep = i > 0;
            return true;
        }
        const long Ll = (long)i * G + c; if (Ll >= nwg && job != J_G5) return false;
        const int L = (int)Ll;
        if (job == J_DFTL) {
            const int b = L >> 4, part = (L >> 3) & 1, pm = L & 7;
            u.A = A + ((size_t)pm * 256 * 4096 + part * 2048) * 2; u.B = B + ((size_t)b * 256 * 4096 + part * 2048) * 2; u.nt = 32;
            u.r0 = TC + b * 2048 + pm * 256; u.c0 = part * 256; u.z = 0; u.keep = 0; return true;
        }
        if (job == J_DFTC) {
            const int b = L >> 1, part = L & 1;
            u.A = A + (size_t)(part * 256) * 2; u.B = B + ((size_t)b * 256 * 512 + part * 256) * 2; u.nt = 4; u.r0 = b * 256; u.c0 = part * 256; u.z = 0; u.keep = 0; return true;
        }
        if (job == J_SGU) {
            const int pair = L / 24, pn = L % 24;
            u.A = A + (size_t)pair * 256 * 256 * 2; u.B = B + ((size_t)pair * 6144 + pn * 256) * 256 * 2; u.nt = 4; u.r0 = 0; u.c0 = pn * 256; u.z = pair; u.keep = 0; return true;
        }
        if (job == J_G5) {
            const int ntm = nt * 3 / 4, nth = nt - ntm;
            int tile, koff, ntu, z;
            if (c < 192) { if (i > 0) return false; tile = c; koff = 0; ntu = ntm; z = 0; }
            else { if (i >= 3) return false; tile = 3 * (c - 192) + i; koff = ntm * 64; ntu = nth; z = 1; }
            int pm, pn; xcd_decode(tile, 48, 4, 192, pm, pn);
            u.A = A + ((size_t)pm * 256 * lda + koff) * 2; u.B = B + ((size_t)pn * 256 * ldb + koff) * 2; u.nt = ntu; u.r0 = pm * 256; u.c0 = pn * 256; u.z = z + 2 * tile; u.keep = 0;
            return true;
        }
        int pm, pn; xcd_decode(L, nM, nN, nwg, pm, pn);
        u.A = A + (size_t)pm * 256 * lda * 2; u.B = B + (size_t)pn * 256 * ldb * 2; u.nt = nt; u.r0 = pm * 256; u.c0 = pn * 256; u.z = 0; u.keep = 0;
        return true;
    }
};

struct Epi {
    int job, l;
    const Params& p;
    DI void operator()(const f32x4 (&acc)[2][2][4][2], const pg8::Unit& u, int wr, int wc, int fr, int fq) const {
        unsigned char* ws = p.ws;
        const int rbase = u.r0 + wr * 64 + fr, cbase = u.c0 + wc * 32 + 8 * fq;
#define EPI_LOOP_AI for (int ai = 0; ai < 2; ++ai) _Pragma("unroll") for (int bj = 0; bj < 2; ++bj)
#define EPI_LOOP_MB _Pragma("unroll") for (int m = 0; m < 4; ++m)
#define EPI_SB asm volatile("" ::: "memory")
#define EPI_RC const int row = rbase + ai * 128 + m * 16, col = cbase + bj * 128; (void)row; (void)col
#define EPI_V float v[8]; _Pragma("unroll") for (int j = 0; j < 4; ++j) { v[j] = acc[ai][bj][m][0][j]; v[4 + j] = acc[ai][bj][m][1][j]; }
        switch (job) {
        case J_G1A: {
            if (u.c0 < NPROJ) {
#pragma unroll
                EPI_LOOP_AI { EPI_LOOP_MB { EPI_RC; EPI_V;
                    if (u.c0 >= 1280) {
#pragma unroll
                        for (int j = 0; j < 8; ++j) v[j] = gelu_tanh(v[j]); }
                    *(u32x4*)((bf16_t*)(ws + WS_PROJ) + (size_t)row * NPROJ + col) = pack8(v); } }
            } else {
#pragma unroll
                EPI_LOOP_AI { EPI_LOOP_MB { EPI_RC; EPI_V;
#pragma unroll
                    for (int j = 0; j < 8; ++j) v[j] = sigmoidf_(v[j]);
                    *(u32x4*)((bf16_t*)(ws + WS_GATES) + (size_t)row * 4096 + (col - NPROJ)) = pack8(v); } }
            }
        } break;
        case J_G1B: {
#pragma unroll
            EPI_LOOP_AI { EPI_LOOP_MB { EPI_RC; EPI_V;
                const int g = row >> 7, cs = (row >> 6) & 1, cp = row & 63, t = col;
                bf16_t* dst;
                if (t < TC) { const int b = t >> 8, k = t & 255; dst = (bf16_t*)(ws + WS_ZTC) + ((size_t)(b * 256 + g * 64 + cp) * 512 + cs * 256 + k); }
                else { const int tl = t - TC, b = tl >> 11, k = tl & 2047; dst = (bf16_t*)(ws + WS_ZTL) + ((size_t)(b * 256 + g * 64 + cp) * 4096 + cs * 2048 + k); }
                *(u32x4*)dst = pack8(v); } }
        } break;
        case J_DFTL: case J_DFTC: {
#pragma unroll
            EPI_LOOP_AI { EPI_LOOP_MB { EPI_RC; EPI_V; *(u32x4*)((bf16_t*)(ws + WS_BR) + (size_t)row * 1280 + col) = pack8(v); } }
        } break;
        case J_SGU: {
            const int q0 = wr * 64 + fr, ch0 = u.z * 128 + (wc & 1) * 32 + 8 * fq, tok0 = ((u.c0 >> 6) + (wc >> 1)) * 128 + q0;
            const bf16_t* dub = (const bf16_t*)(ws + WS_PROJ) + (size_t)tok0 * NPROJ + 1280 + ch0;
            bf16_t* ob = (bf16_t*)(ws + WS_BR) + (size_t)tok0 * 1280 + 1024 + ch0;
            const float* bb = p.in[23] + (l * 4 + u.z * 2) * 128 + q0;
#pragma unroll
            EPI_LOOP_AI {
                EPI_SB; u32x4 duw[4]; float bias[4];
                EPI_LOOP_MB { duw[m] = *(const u32x4*)(dub + (size_t)(bj * 256 + m * 16) * NPROJ + ai * 64); bias[m] = bb[ai * 128 + m * 16]; }
                EPI_LOOP_MB { EPI_V; float du[8]; unpack8(duw[m], du);
#pragma unroll
                    for (int j = 0; j < 8; ++j) v[j] = du[j] * (v[j] + bias[m]);
                    *(u32x4*)(ob + (size_t)(bj * 256 + m * 16) * 1280 + ai * 64) = pack8(v); }
            }
        } break;
        case J_G2: {
            const bf16_t* gbase = (const bf16_t*)(ws + WS_GATES) + u.z * 1024;
            if (u.z == 3) {
#pragma unroll
                EPI_LOOP_AI {
                    EPI_SB; u32x4 g0[4];
                    EPI_LOOP_MB { EPI_RC; g0[m] = *(const u32x4*)(gbase + (size_t)row * 4096 + col); }
                    EPI_LOOP_MB { EPI_RC; EPI_V; float gt[8]; unpack8(g0[m], gt);
#pragma unroll
                        for (int j = 0; j < 8; ++j) v[j] *= gt[j];
                        *(u32x4*)((bf16_t*)(ws + WS_MERGED) + (size_t)row * 1024 + col) = pack8(v); }
                }
            }
        } break;
        case J_G3: case J_G5: {
            const int tile = u.z >> 1;
            unsigned* flag = (unsigned*)(ws + CTL_FLAG) + tile;
            const unsigned want = (unsigned)(2 * l + (job == J_G5 ? 2 : 1));
            const char* ppb = (const char*)(ws + WS_H) + (size_t)tile * 32 * 512 * 16;
            const unsigned pvo = TIDX * 16u;
            if (u.z & 1) {
#pragma unroll
                for (int ai = 0; ai < 2; ++ai)
#pragma unroll
                    for (int bj = 0; bj < 2; ++bj)
#pragma unroll
                        for (int m = 0; m < 4; ++m)
#pragma unroll
                            for (int n = 0; n < 2; ++n) { const unsigned o_ = pvo + (unsigned)((((ai * 2 + bj) * 4 + m) * 2 + n) * 8192); const f32x4 d_ = acc[ai][bj][m][n];
                                asm volatile("global_store_dwordx4 %0, %1, %2 sc0 sc1" :: "v"(o_), "v"(d_), "s"(ppb) : "memory"); }
                asm volatile("s_waitcnt vmcnt(0)" ::: "memory");
                __syncthreads();
                if (TIDX == 0) __hip_atomic_store(flag, want, __ATOMIC_RELAXED, __HIP_MEMORY_SCOPE_AGENT);
                break;
            }
            const int mi = u.r0 < TC ? 0 : 1 + ((u.r0 - TC) >> 11);
            const float* gmod = (const float*)(ws + CTL_MOD) + (size_t)(l * 3 + mi) * 6144 + (job == J_G3 ? 2048 : 5120);
            const bool from_in = (job == J_G3 && l == 0);
            const float* xin = from_in ? (u.r0 < TC ? p.in[0] : p.in[1] - (size_t)TC * 1024) : p.out;
            f32x4 gm[2][2];
#pragma unroll
            for (int bj = 0; bj < 2; ++bj) { gm[bj][0] = *(const f32x4*)(gmod + cbase + bj * 128); gm[bj][1] = *(const f32x4*)(gmod + cbase + bj * 128 + 4); }
#pragma unroll
            EPI_LOOP_AI {
                EPI_SB; f32x4 xv[4][2];
                EPI_LOOP_MB { EPI_RC; const float* xi = xin + (size_t)row * 1024 + col; xv[m][0] = *(const f32x4*)xi; xv[m][1] = *(const f32x4*)(xi + 4); }
                EPI_LOOP_MB { EPI_RC; float* xo = p.out + (size_t)row * 1024 + col;
                    *(f32x4*)xo = xv[m][0] + gm[bj][0] * acc[ai][bj][m][0]; *(f32x4*)(xo + 4) = xv[m][1] + gm[bj][1] * acc[ai][bj][m][1]; }
            }
        } break;
        case J_G4: {
#pragma unroll
            EPI_LOOP_AI { EPI_LOOP_MB { EPI_RC; EPI_V;
#pragma unroll
                for (int j = 0; j < 8; ++j) { const float r = fmaxf(v[j], 0.f); v[j] = r * r; }
                *(u32x4*)((bf16_t*)(ws + WS_GATES) + (size_t)row * 4096 + col) = pack8(v); } }
        } break;
        default: break;
        }
#undef EPI_LOOP_AI
#undef EPI_SB
#undef EPI_LOOP_MB
#undef EPI_RC
#undef EPI_V
    }
    DI void pre(f32x4 (&acc)[2][2][4][2], const pg8::Unit& u) const {
        if (!(job == J_G5 && !(u.z & 1))) return;
        const int tile = u.z >> 1;
        unsigned* flag = (unsigned*)(p.ws + CTL_FLAG) + tile;
        const unsigned want = (unsigned)(2 * l + (job == J_G5 ? 2 : 1));
        const char* ppb = (const char*)(p.ws + WS_H) + (size_t)tile * 32 * 512 * 16;
        const unsigned pvo = TIDX * 16u;
        if (TIDX == 0) { unsigned sp_ = 0; while (__hip_atomic_load(flag, __ATOMIC_RELAXED, __HIP_MEMORY_SCOPE_AGENT) < want) { __builtin_amdgcn_s_sleep(1); if (++sp_ > (1u << 22)) break; } }
        __syncthreads();
#pragma unroll
        for (int ai = 0; ai < 2; ++ai)
#pragma unroll
            for (int bj = 0; bj < 2; ++bj) {
                const unsigned o_ = pvo + (unsigned)(((ai * 2 + bj) * 8) * 8192);
                f32x4 q0, q1, q2, q3, q4, q5, q6, q7;
                asm volatile("global_load_dwordx4 %0, %8, %16 sc0 sc1\n\tglobal_load_dwordx4 %1, %9, %16 sc0 sc1\n\tglobal_load_dwordx4 %2, %10, %16 sc0 sc1\n\tglobal_load_dwordx4 %3, %11, %16 sc0 sc1\n\t"
                             "global_load_dwordx4 %4, %12, %16 sc0 sc1\n\tglobal_load_dwordx4 %5, %13, %16 sc0 sc1\n\tglobal_load_dwordx4 %6, %14, %16 sc0 sc1\n\tglobal_load_dwordx4 %7, %15, %16 sc0 sc1\n\ts_waitcnt vmcnt(0)"
                             : "=&v"(q0), "=&v"(q1), "=&v"(q2), "=&v"(q3), "=&v"(q4), "=&v"(q5), "=&v"(q6), "=&v"(q7)
                             : "v"(o_), "v"(o_ + 8192u), "v"(o_ + 16384u), "v"(o_ + 24576u), "v"(o_ + 32768u), "v"(o_ + 40960u), "v"(o_ + 49152u), "v"(o_ + 57344u), "s"(ppb) : "memory");
                acc[ai][bj][0][0] += q0; acc[ai][bj][0][1] += q1; acc[ai][bj][1][0] += q2; acc[ai][bj][1][1] += q3;
                acc[ai][bj][2][0] += q4; acc[ai][bj][2][1] += q5; acc[ai][bj][3][0] += q6; acc[ai][bj][3][1] += q7;
            }
    }
    DI void scale(f32x4 (&acc)[2][2][4][2], const pg8::Unit& u, int wr, int wc, int fr, int fq) const {
        if (!(job == J_G2 && u.z < 3)) return;
        const bf16_t* gbase = (const bf16_t*)(p.ws + WS_GATES) + u.z * 1024 + (size_t)(u.r0 + wr * 64 + fr) * 4096 + u.c0 + wc * 32 + 8 * fq;
#pragma unroll
        for (int ai = 0; ai < 2; ++ai)
#pragma unroll
            for (int m = 0; m < 4; m += 2) {
                u32x4 g0[2][2], g1[2][2];
#pragma unroll
                for (int mm = 0; mm < 2; ++mm)
#pragma unroll
                    for (int bj = 0; bj < 2; ++bj) { const bf16_t* gp = gbase + (size_t)(ai * 128 + (m + mm) * 16) * 4096 + bj * 128; g0[mm][bj] = *(const u32x4*)gp; g1[mm][bj] = *(const u32x4*)(gp + 1024); }
#pragma unroll
                for (int mm = 0; mm < 2; ++mm)
#pragma unroll
                    for (int bj = 0; bj < 2; ++bj) {
                        float gt[8], gn[8]; unpack8(g0[mm][bj], gt); unpack8(g1[mm][bj], gn);
#pragma unroll
                        for (int j = 0; j < 8; ++j) gt[j] *= __builtin_amdgcn_rcpf(fmaxf(gn[j], 1e-30f));
#pragma unroll
                        for (int j = 0; j < 4; ++j) { acc[ai][bj][m + mm][0][j] *= gt[j]; acc[ai][bj][m + mm][1][j] *= gt[4 + j]; }
                    }
                asm volatile("" ::: "memory");
            }
    }
};

DI void transpose_item(const float* W, int ld, int ncols, bf16_t* WT, int ldw, int koff, int row_off, LAS float* scr, int item, int lane) {
    const int nblk = ncols / 32, kb = item / nblk, nb = item % nblk, k0 = 64 * kb, n0 = 32 * nb;
    float tv[32];
#pragma unroll
    for (int i = 0; i < 32; ++i) { const int kk = 2 * i + (lane >> 5); tv[i] = W[(size_t)(k0 + kk) * ld + n0 + (lane & 31)]; }
#pragma unroll
    for (int i = 0; i < 32; ++i) { const int kk = 2 * i + (lane >> 5); scr[kk * 33 + (lane & 31)] = tv[i]; }
    asm volatile("s_waitcnt lgkmcnt(0)" ::: "memory");
    const int c = lane & 7;
#pragma unroll
    for (int j = 0; j < 4; ++j) { const int n = (lane >> 3) + 8 * j; const LAS float* s = scr + (8 * c) * 33 + n;
        u32x4 o; o.x = cvtpk(s[0 * 33], s[1 * 33]); o.y = cvtpk(s[2 * 33], s[3 * 33]); o.z = cvtpk(s[4 * 33], s[5 * 33]); o.w = cvtpk(s[6 * 33], s[7 * 33]);
        *(u32x4*)(WT + (size_t)(row_off + n0 + n) * ldw + koff + k0 + 8 * c) = o; }
    asm volatile("s_waitcnt lgkmcnt(0)" ::: "memory");
}

DI void prologue(const Params& p, LAS unsigned char* lds, const int lbeg, const int nl, const int vb, const int nvb, const bool common) {
    const int tid_ = opaque_v(TIDX), lane = tid_ & 63, wave = __builtin_amdgcn_readfirstlane(tid_ >> 6), gw = vb * NWAVES + wave, NGW = nvb * NWAVES;
    unsigned char* ws = p.ws;
    LAS float* scr = (LAS float*)(lds + wave * 8448);
    LAS float* tw = (LAS float*)(lds + 8 * 8448);
    if (TIDX < 128) { const int m = TIDX & 63; const float a = (float)m * (2.0f / 64.0f); tw[TIDX] = TIDX < 64 ? cospif(a) : sinpif(a); }
    __syncthreads();
    for (int it = gw; it < nl * 7936; it += NGW) {
        const int l = lbeg + it / 7936; int r = it % 7936;
        unsigned char* wl = ws + WS_W + (size_t)l * W_LAYER;
        if (r < 896) { transpose_item(p.in[12] + (size_t)l * 1024 * 2048 + 256, 2048, 1792, (bf16_t*)(wl + W_CAT), 1024, 0, 0, scr, r, lane); continue; } r -= 896;
        if (r < 2048) { transpose_item(p.in[24] + (size_t)l * 1024 * 4096, 4096, 4096, (bf16_t*)(wl + W_CAT), 1024, 0, 1792, scr, r, lane); continue; } r -= 2048;
        if (r < 384) { const int n = r / 128 + 1; transpose_item(p.in[25] + (size_t)(l * 4 + n) * 256 * 1024, 1024, 1024, (bf16_t*)(wl + W_BALL), 1280, 256 + 256 * n, 0, scr, r % 128, lane); continue; } r -= 384;
        if (r < 512) { transpose_item(p.in[26] + (size_t)l * 1024 * 1024, 1024, 1024, (bf16_t*)(wl + W_OUT), 1024, 0, 0, scr, r, lane); continue; } r -= 512;
        if (r < 2048) { transpose_item(p.in[27] + (size_t)l * 1024 * 4096, 4096, 4096, (bf16_t*)(wl + W_1), 1024, 0, 0, scr, r, lane); continue; } r -= 2048;
        transpose_item(p.in[28] + (size_t)l * 4096 * 1024, 1024, 1024, (bf16_t*)(wl + W_2), 4096, 0, 0, scr, r, lane);
    }
    {
        LAS f32x4* red = (LAS f32x4*)(lds + 69632);
        for (int bi = vb; bi < nl * 24; bi += nvb) {
            const int l = lbeg + bi / 24, cc = bi % 24, n0 = cc * 256 + lane * 4, k0 = wave * 128;
            f32x4 a0 = {0.f, 0.f, 0.f, 0.f}, a1 = a0, a2 = a0;
            const float* wp = p.in[8] + ((size_t)l * 1024 + k0) * 6144 + n0;
#pragma unroll 32
            for (int kk = 0; kk < 128; ++kk) {
                const f32x4 w = *(const f32x4*)(wp + (size_t)kk * 6144);
                const float c0 = p.in[7][k0 + kk], c1 = p.in[2][k0 + kk], c2 = p.in[2][1024 + k0 + kk];
                const float s0 = c0 * sigmoidf_(c0), s1 = c1 * sigmoidf_(c1), s2 = c2 * sigmoidf_(c2);
                a0 += w * s0; a1 += w * s1; a2 += w * s2;
            }
            red[(wave * 3 + 0) * 64 + lane] = a0; red[(wave * 3 + 1) * 64 + lane] = a1; red[(wave * 3 + 2) * 64 + lane] = a2;
            __syncthreads();
            if (TIDX < 192) {
                const int m = TIDX >> 6, ln = TIDX & 63;
                f32x4 sacc = *(const f32x4*)(p.in[9] + (size_t)l * 6144 + cc * 256 + ln * 4);
#pragma unroll
                for (int w = 0; w < 8; ++w) sacc += red[(w * 3 + m) * 64 + ln];
                *(f32x4*)((float*)(ws + CTL_MOD) + (size_t)(l * 3 + m) * 6144 + cc * 256 + ln * 4) = sacc;
            }
            __syncthreads();
        }
    }
    for (int it = (gw >= 1024 ? gw - 1024 : gw + NGW - 1024); it < nl * 128; it += NGW) {
        const int l = lbeg + it / 128, r = it % 128, g = r / 32, cs = (r / 16) & 1, d = (r % 16) * 64 + lane;
        float x[64];
        const float* src = p.in[12] + ((size_t)l * 1024 + d) * 2048 + g * 64;
#pragma unroll
        for (int j = 0; j < 16; ++j) { const f32x4 w = *(const f32x4*)(src + 4 * j); x[4 * j] = w[0]; x[4 * j + 1] = w[1]; x[4 * j + 2] = w[2]; x[4 * j + 3] = w[3]; }
        bf16_t* dst = (bf16_t*)(ws + WS_W + (size_t)l * W_LAYER + W_A) + (size_t)(g * 128 + cs * 64) * 1024 + d;
        for (int cp = 0; cp < 64; ++cp) {
            float a = 0.f;
#pragma unroll
            for (int c = 0; c < 64; ++c) a += x[c] * tw[cs * 64 + ((c * cp) & 63)];
            dst[(size_t)cp * 1024] = (bf16_t)(cvtpk(a * 0.125f, 0.f) & 0xffffu);
        }
    }
    for (int it = gw; it < nl * 512; it += NGW) {
        const int l = lbeg + it / 512, r = it % 512, r0 = (r / 16) * 8, d = (r % 16) * 64 + lane;
        float a[8];
#pragma unroll
        for (int j = 0; j < 8; ++j) a[j] = 0.f;
        const float* wb = p.in[25] + (size_t)(l * 4) * 256 * 1024 + d;
        const float* wf = p.in[13] + ((size_t)l * 256 + r0) * 256;
#pragma unroll 2
        for (int jb = 0; jb < 256; jb += 8) {
            float b[8];
#pragma unroll
            for (int jj = 0; jj < 8; ++jj) b[jj] = wb[(size_t)(jb + jj) * 1024];
#pragma unroll
            for (int rr = 0; rr < 8; ++rr)
#pragma unroll
                for (int jj = 0; jj < 8; ++jj) a[rr] += wf[rr * 256 + jb + jj] * b[jj];
        }
        bf16_t* dst = (bf16_t*)(ws + WS_W + (size_t)l * W_LAYER + W_BALL) + (size_t)d * 1280 + r0;
        const u32x4 o = pack8(a);
        *(u32x4*)dst = o; *(u32x4*)(dst + 256) = o;
    }
    for (int it = gw - (NGW >= 2048 ? 1536 : 0); it >= 0 && it < nl * 256; it += NGW - (NGW >= 2048 ? 1536 : 0)) {
        const int idx = it * 64 + lane, k8 = idx & 31, m = (idx >> 5) & 255, pair = (idx >> 13) & 1, l = lbeg + (idx >> 14);
        const int gsel = m >> 7, q = m & 127, ksel = k8 >> 4, p0 = (k8 & 15) * 8;
        u32x4 o = {0u, 0u, 0u, 0u};
        if (gsel == ksel) { const float* s = p.in[22] + ((size_t)(l * 4 + pair * 2 + gsel) * 128 + q) * 128 + p0; float f[8];
#pragma unroll
            for (int j = 0; j < 8; ++j) f[j] = s[j];
            o = pack8(f); }
        *(u32x4*)((bf16_t*)(ws + WS_W + (size_t)l * W_LAYER + W_SP) + ((size_t)pair * 256 + m) * 256 + k8 * 8) = o;
    }
    if (common)
    for (int it = gw; it < 256 + 16384; it += NGW) {
        const bool ctx = it < 256;
        const int idx = (ctx ? it : it - 256) * 64 + lane;
        const int L = ctx ? 256 : 2048, c8n = ctx ? 64 : 512;
        const int j = idx / c8n, kk0 = (idx % c8n) * 8;
        const float sc = ctx ? 0.0625f : 0.022097086912079608f;
        float f[8];
#pragma unroll
        for (int e = 0; e < 8; ++e) { const int kk = kk0 + e, part = kk >= L, k = kk & (L - 1), mm = (j * k) & (L - 1);
            const float a = (float)(2 * mm) / (float)L; f[e] = (part ? -sinpif(a) : cospif(a)) * sc; }
        *(u32x4*)((bf16_t*)(ws + (ctx ? WS_FCTX : WS_FLAT)) + (size_t)j * (2 * L) + kk0) = pack8(f);
    }
    if (common && blockIdx.x == 0 && TIDX < 4) {
        const int l = TIDX; float s1 = 0.f, s2 = 0.f;
        for (int i = 0; i < 32; ++i) { s1 += p.in[16][l * 32 + i] * p.in[17][l * 32 + i]; s2 += p.in[18][l * 32 + i] * p.in[19][l * 32 + i]; }
        const float lam_init = 0.8f - 0.6f * expf(-0.3f * (float)l);
        ((float*)(ws + CTL_LAM))[l] = expf(s1) - expf(s2) + lam_init;
    }
}

DI void norm_phase(const Params& p, int l, int which) {
    const int tid_ = opaque_v(TIDX), lane = tid_ & 63, wave = __builtin_amdgcn_readfirstlane(tid_ >> 6), gw = blockIdx.x * NWAVES + wave, NGW = gridDim.x * NWAVES;
    unsigned char* ws = p.ws;
    constexpr int KR = 3;
    const float* gg = (which == 0 ? p.in[10] + l * 1024 : which == 1 ? p.in[11] + l * 1024 : p.in[29]);
    for (int row0 = gw; row0 < T; row0 += KR * NGW) {
        f32x4 v[KR][4]; float ss[KR];
#pragma unroll
        for (int k = 0; k < KR; ++k) { const int row = row0 + k * NGW < T ? row0 + k * NGW : row0;
            const float* xr = (l == 0 && which == 0) ? (row < TC ? p.in[0] + (size_t)row * 1024 : p.in[1] + (size_t)(row - TC) * 1024) : p.out + (size_t)row * 1024;
#pragma unroll
            for (int j = 0; j < 4; ++j) v[k][j] = *(const f32x4*)(xr + 4 * lane + 256 * j); }
#pragma unroll
        for (int k = 0; k < KR; ++k) { float s_ = 0.f;
#pragma unroll
            for (int j = 0; j < 4; ++j) s_ += (v[k][j].x * v[k][j].x + v[k][j].y * v[k][j].y) + (v[k][j].z * v[k][j].z + v[k][j].w * v[k][j].w);
            ss[k] = s_; }
#pragma unroll
        for (int o = 1; o < 64; o <<= 1) {
#pragma unroll
            for (int k = 0; k < KR; ++k) ss[k] += __shfl_xor(ss[k], o); }
#pragma unroll
        for (int k = 0; k < KR; ++k) {
            const int row = row0 + k * NGW;
            if (row >= T) break;
            const float rms = rsqrtf(ss[k] * (1.f / 1024.f) + EPS);
            if (which < 2) {
                const int mi = row < TC ? 0 : 1 + ((row - TC) >> 11);
                const float* md = (const float*)(ws + CTL_MOD) + (size_t)(l * 3 + mi) * 6144;
                const float* shp = md + (which == 0 ? 0 : 3072); const float* scp = md + (which == 0 ? 1024 : 4096);
                bf16_t* o = (bf16_t*)(ws + WS_H) + (size_t)row * 1024;
#pragma unroll
                for (int j = 0; j < 4; ++j) { const int c = 4 * lane + 256 * j; const f32x4 g = *(const f32x4*)(gg + c), sc = *(const f32x4*)(scp + c), sh = *(const f32x4*)(shp + c);
                    const f32x4 y = v[k][j] * rms * g * (sc + 1.f) + sh;
                    u32x2 w; w.x = cvtpk(y.x, y.y); w.y = cvtpk(y.z, y.w); *(u32x2*)(o + c) = w; }
            } else {
                float* o = p.out + (size_t)row * 1024;
#pragma unroll
                for (int j = 0; j < 4; ++j) { const int c = 4 * lane + 256 * j; const f32x4 g = *(const f32x4*)(gg + c); *(f32x4*)(o + c) = v[k][j] * rms * g; }
            }
        }
    }
}

template <int N> DI void load_bf(const bf16_t* src, float* v) {
#pragma unroll
    for (int j = 0; j < N / 8; ++j) unpack8(*(const u32x4*)(src + 8 * j), v + 8 * j);
}
template <int N> DI void load_f32(const float* src, float* v) {
#pragma unroll
    for (int j = 0; j < N / 4; ++j) { const f32x4 w = *(const f32x4*)(src + 4 * j); v[4 * j] = w[0]; v[4 * j + 1] = w[1]; v[4 * j + 2] = w[2]; v[4 * j + 3] = w[3]; }
}
template <int N> DI void store_bf(bf16_t* dst, const float* v) {
#pragma unroll
    for (int j = 0; j < N / 8; ++j) *(u32x4*)(dst + 8 * j) = pack8(v + 8 * j);
}
template <int N> DI void store_f32(float* dst, const float* v) {
#pragma unroll
    for (int j = 0; j < N / 4; ++j) *(f32x4*)(dst + 4 * j) = (f32x4){v[4 * j], v[4 * j + 1], v[4 * j + 2], v[4 * j + 3]};
}
template <int N> DI void store_tr(bf16_t* dst, size_t stride, const float* v) {
#pragma unroll
    for (int d = 0; d < N; d += 2) { const unsigned w = cvtpk(v[d], v[d + 1]); dst[(size_t)d * stride] = (bf16_t)(w & 0xffffu); dst[(size_t)(d + 1) * stride] = (bf16_t)(w >> 16); }
}
template <int N> DI void store_kfrag(bf16_t* base, int key, const float* v) {
    const int tile = key >> 5, r = key & 31;
#pragma unroll
    for (int s = 0; s < N / 16; ++s)
#pragma unroll
        for (int h = 0; h < 2; ++h) *(u32x4*)(base + ((size_t)((tile * (N / 16) + s) * 64 + h * 32 + r)) * 8) = pack8(v + 16 * s + 8 * h);
}
DI void store_vfrag(bf16_t* base, int key, const float* v) {
    const int tile = key >> 5, sp = (key >> 4) & 1, kk = key & 15, h = (kk >> 2) & 1, j = ((kk >> 3) << 2) | (kk & 3);
    bf16_t* b0 = base + ((size_t)(tile * 4 + sp) * 64 + h * 32) * 8 + j;
#pragma unroll
    for (int d = 0; d < 64; d += 2) { const unsigned w = cvtpk(v[d], v[d + 1]);
        b0[(size_t)((d >> 5) * 2 * 64 + (d & 31)) * 8] = (bf16_t)(w & 0xffffu); b0[(size_t)((d >> 5) * 2 * 64 + ((d + 1) & 31)) * 8] = (bf16_t)(w >> 16); }
}
template <int N> DI void rms_scale(float* v, const float* g) {
    float ss = 0.f;
#pragma unroll
    for (int d = 0; d < N; ++d) ss += v[d] * v[d];
    const float r = rsqrtf(ss * (1.f / N) + EPS);
#pragma unroll
    for (int d = 0; d < N; ++d) v[d] = v[d] * r * g[d];
}
template <int N> DI void rope(float* v, int pos) {
#pragma unroll
    for (int i0 = 0; i0 < N / 2; i0 += 8) {
        const int pk = opaque_v(pos);
        const float frow = (float)(pk >> 6), fcol = (float)(pk & 63);
#pragma unroll
        for (int i = i0; i < i0 + 8; ++i) {
            const int q = i % (N / 4);
            const float inv = exp2f(-(float)q * (13.287712379549449f / (float)(N / 4)));
            const float ang = (i < N / 4 ? frow : fcol) * inv;
            const float c = __cosf(ang), s = __sinf(ang);
            const float x1 = v[i], x2 = v[i + N / 2];
            v[i] = x1 * c - x2 * s; v[i + N / 2] = x1 * s + x2 * c;
        }
    }
}

DI void pp_phase(const Params& p, int l) {
    const int tid_ = opaque_v(TIDX), lane = tid_ & 63, wave = __builtin_amdgcn_readfirstlane(tid_ >> 6), gw = blockIdx.x * NWAVES + wave, NGW = gridDim.x * NWAVES;
    unsigned char* ws = p.ws;
    const bf16_t* proj = (const bf16_t*)(ws + WS_PROJ);
    unsigned char* att = ws + WS_ATT;
    constexpr int NT_ITEMS = 192 * 29, NC_ITEMS = 16 * 16;
    for (int it = gw; it < NT_ITEMS + NC_ITEMS; it += NGW) {
        if (it < NT_ITEMS) {
            const int tile = it / 29, task = it % 29, t = tile * 64 + lane;
            const bool ctx = t < TC;
            const int b = ctx ? (t >> 8) : ((t - TC) >> 11), s = ctx ? (t & 255) : ((t - TC) & 2047);
            const bf16_t* prow = proj + (size_t)t * NPROJ;
            if (task < 4) {
                float v[64]; load_bf<64>(prow + task * 64, v);
                rms_scale<64>(v, p.in[14] + l * 64);
                if (!ctx) rope<64>(v, s);
                store_bf<64>((bf16_t*)(att + A_QB) + (size_t)t * 256 + task * 64, v);
            } else if (task < 6) {
                const int hk = task - 4;
                float v[64]; load_bf<64>(prow + 256 + hk * 64, v);
                rms_scale<64>(v, p.in[15] + l * 64);
                if (ctx) { store_f32<64>(p.out + O_GK + ((size_t)((b * 4 + l) * 256 + s) * 2 + hk) * 64, v);
                           store_kfrag<64>((bf16_t*)(att + A_KBC) + (size_t)(b * 2 + hk) * 256 * 64, s, v); }
                else { rope<64>(v, s); store_kfrag<64>((bf16_t*)(att + A_KBL) + (size_t)(b * 2 + hk) * 2560 * 64, 512 + s, v); }
            } else if (task < 8) {
                const int hk = task - 6;
                float v[64]; load_bf<64>(prow + 384 + hk * 64, v);
                if (ctx) { store_f32<64>(p.out + O_GV + ((size_t)((b * 4 + l) * 256 + s) * 2 + hk) * 64, v);
                           store_vfrag((bf16_t*)(att + A_VBC) + (size_t)(b * 2 + hk) * 64 * 256, s, v); }
                else store_vfrag((bf16_t*)(att + A_VBL) + (size_t)(b * 2 + hk) * 64 * 2560, 512 + s, v);
            } else if (task < 16) {
                const int hm = task - 8;
                (void)hm;
            } else if (task < 24) {
                const int hm = task - 16;
                float v[32]; load_bf<32>(prow + 768 + hm * 32, v);
                if (ctx) { store_f32<32>(p.out + O_DK + ((size_t)((b * 4 + l) * 256 + s) * 8 + hm) * 32, v);
                           store_kfrag<32>((bf16_t*)(att + A_KCC) + (size_t)(b * 8 + hm) * 256 * 32, s, v); }
                else { rope<32>(v, s); store_kfrag<32>((bf16_t*)(att + A_KCL) + (size_t)(b * 8 + hm) * 2560 * 32, 512 + s, v); }
            } else if (task < 28) {
                const int h = task - 24;
                float v[64]; load_bf<64>(prow + 1024 + h * 64, v);
                if (ctx) { store_f32<64>(p.out + O_DV + ((size_t)((b * 4 + l) * 256 + s) * 4 + h) * 64, v);
                           store_vfrag((bf16_t*)(att + A_VCC) + (size_t)(b * 4 + h) * 64 * 256, s, v); }
                else store_vfrag((bf16_t*)(att + A_VCL) + (size_t)(b * 4 + h) * 64 * 2560, 512 + s, v);
            } else {
                float ss = 0.f;
#pragma unroll 1
                for (int jb = 0; jb < 32; jb += 8) {
                    u32x4 rw[8];
#pragma unroll
                    for (int j = 0; j < 8; ++j) rw[j] = *(const u32x4*)(prow + 1536 + 8 * (jb + j));
#pragma unroll
                    for (int j = 0; j < 8; ++j) { float v[8]; unpack8(rw[j], v);
#pragma unroll
                        for (int e = 0; e < 8; ++e) ss += v[e] * v[e]; }
                }
                const float r = rsqrtf(ss * (1.f / 256.f) + EPS);
                const int chunk = t >> 7, pp = t & 127;
                const float* sg = p.in[21] + l * 256;
                bf16_t* dvt = (bf16_t*)(ws + WS_DVT);
#pragma unroll 1
                for (int jb = 0; jb < 32; jb += 8) {
                    u32x4 rw[8];
#pragma unroll
                    for (int j = 0; j < 8; ++j) rw[j] = *(const u32x4*)(prow + 1536 + 8 * (jb + j));
                    const int g = jb >> 3;
                    bf16_t* d0 = dvt + ((size_t)((g >> 1) * 6144 + chunk * 64) * 256 + (g & 1) * 128 + pp);
#pragma unroll
                    for (int j = 0; j < 8; ++j) { float v[8]; unpack8(rw[j], v);
                        const f32x4 s0 = *(const f32x4*)(sg + 8 * (jb + j)), s1 = *(const f32x4*)(sg + 8 * (jb + j) + 4);
                        const float sv[8] = {s0.x, s0.y, s0.z, s0.w, s1.x, s1.y, s1.z, s1.w};
#pragma unroll
                        for (int e = 0; e < 8; e += 2) { const int c = 8 * j + e;
                            const unsigned w = cvtpk(v[e] * r * sv[e], v[e + 1] * r * sv[e + 1]);
                            d0[(size_t)c * 256] = (bf16_t)(w & 0xffffu); d0[(size_t)(c + 1) * 256] = (bf16_t)(w >> 16); } }
                }
            }
        } else {
            const int ci = it - NT_ITEMS, tile = ci / 16, task = ci % 16, ct = tile * 64 + lane, b = ct >> 9, pos = ct & 511;
            const size_t crow = (size_t)(b * 4 + l) * 512 + pos;
            if (task < 2) { float v[64]; load_f32<64>(p.in[3] + (crow * 2 + task) * 64, v); store_kfrag<64>((bf16_t*)(att + A_KBL) + (size_t)(b * 2 + task) * 2560 * 64, pos, v); }
            else if (task < 4) { const int hk = task - 2; float v[64]; load_f32<64>(p.in[4] + (crow * 2 + hk) * 64, v); store_vfrag((bf16_t*)(att + A_VBL) + (size_t)(b * 2 + hk) * 64 * 2560, pos, v); }
            else if (task < 12) { const int hm = task - 4; float v[32]; load_f32<32>(p.in[5] + (crow * 8 + hm) * 32, v); store_kfrag<32>((bf16_t*)(att + A_KCL) + (size_t)(b * 8 + hm) * 2560 * 32, pos, v); }
            else { const int h = task - 12; float v[64]; load_f32<64>(p.in[6] + (crow * 4 + h) * 64, v); store_vfrag((bf16_t*)(att + A_VCL) + (size_t)(b * 4 + h) * 64 * 2560, pos, v); }
        }
    }
}

#define MFMA32(a, b, c) __builtin_amdgcn_mfma_f32_32x32x16_bf16((a), (b), (c), 0, 0, 0)
template <int DQK, int NMAP>
DI void attn_core(const bf16_t* Q, int ldq, const bf16_t* K, size_t kmapstride, const bf16_t* VT, int kb, int ke, float cs, f32x16 (&o)[NMAP][2], float (&mrun)[NMAP], float (&lrun)[NMAP], int lane) {
    constexpr int NS = DQK / 16;
    const int r = lane & 31, h = lane >> 5;
    bf16x8 qf[NMAP][NS];
#pragma unroll
    for (int mp = 0; mp < NMAP; ++mp)
#pragma unroll
        for (int s = 0; s < NS; ++s) qf[mp][s] = *(const bf16x8*)(Q + (size_t)r * ldq + mp * 32 + 16 * s + 8 * h);
#pragma unroll
    for (int mp = 0; mp < NMAP; ++mp) { mrun[mp] = -1e30f; lrun[mp] = 0.f;
#pragma unroll
        for (int i = 0; i < 16; ++i) { o[mp][0][i] = 0.f; o[mp][1][i] = 0.f; } }
    const unsigned lo16 = (unsigned)lane * 16u;
    bf16x8 Ka[NMAP][NS], Kb[NMAP][NS], Va[2][2], Vb[2][2];
    f32x16 Sx, Sy;
    bf16x8 P0a, P0b, P1a, P1b;
#define AT_LOADK(Kx, tile) do { _Pragma("unroll") for (int mp_ = 0; mp_ < NMAP; ++mp_) _Pragma("unroll") for (int s_ = 0; s_ < NS; ++s_) \
        Kx[mp_][s_] = *(const bf16x8*)((const char*)K + ((size_t)mp_ * kmapstride + (size_t)((tile) * NS + s_) * 512) * 2 + lo16); } while (0)
#define AT_LOADV(Vx, tile) do { _Pragma("unroll") for (int mt_ = 0; mt_ < 2; ++mt_) _Pragma("unroll") for (int sp_ = 0; sp_ < 2; ++sp_) \
        Vx[mt_][sp_] = *(const bf16x8*)((const char*)VT + (size_t)(((tile) * 2 + mt_) * 2 + sp_) * 1024 + lo16); } while (0)
#define AT_QK(Sd, Kx, mp) do { _Pragma("unroll") for (int i_ = 0; i_ < 16; ++i_) Sd[i_] = 0.f; _Pragma("unroll") for (int s_ = 0; s_ < NS; ++s_) Sd = MFMA32(Kx[mp][s_], qf[mp][s_], Sd); } while (0)
#define AT_PV(Pa_, Pb_, Vx, mp) do { _Pragma("unroll") for (int mt_ = 0; mt_ < 2; ++mt_) { o[mp][mt_] = MFMA32(Vx[mt_][0], Pa_, o[mp][mt_]); o[mp][mt_] = MFMA32(Vx[mt_][1], Pb_, o[mp][mt_]); } } while (0)
#define AT_SOFTMAX(S, mp, Pa_, Pb_) do { \
        float mx = fmaxf(fmaxf(S[0], S[1]), fmaxf(S[2], S[3])); \
        _Pragma("unroll") for (int i = 4; i < 16; i += 4) mx = fmaxf(mx, fmaxf(fmaxf(S[i], S[i + 1]), fmaxf(S[i + 2], S[i + 3]))); \
        { const auto sw_ = __builtin_amdgcn_permlane32_swap(__builtin_bit_cast(unsigned, mx), __builtin_bit_cast(unsigned, mx), false, false); \
          mx = fmaxf(__builtin_bit_cast(float, sw_[0]), __builtin_bit_cast(float, sw_[1])); } \
        if (__builtin_amdgcn_ballot_w64(mx > mrun[mp]) != 0ull) { \
            const float mn = fmaxf(mrun[mp], mx); \
            const float alpha = __builtin_amdgcn_exp2f((mrun[mp] - mn) * cs); \
            mrun[mp] = mn; lrun[mp] *= alpha; \
            o[mp][0] *= alpha; o[mp][1] *= alpha; \
        } \
        const float nb = mrun[mp] * cs; \
        float ps = 0.f; \
        { float pv[8]; _Pragma("unroll") for (int i = 0; i < 8; ++i) { pv[i] = __builtin_amdgcn_exp2f(S[i] * cs - nb); ps += pv[i]; } Pa_ = __builtin_bit_cast(bf16x8, pack8(pv)); } \
        { float pv[8]; _Pragma("unroll") for (int i = 0; i < 8; ++i) { pv[i] = __builtin_amdgcn_exp2f(S[8 + i] * cs - nb); ps += pv[i]; } Pb_ = __builtin_bit_cast(bf16x8, pack8(pv)); } \
        lrun[mp] += ps; \
    } while (0)
    const int t0 = kb >> 5, t1 = ke >> 5, tl = t1 - 1;
#define AT_CL(t) ((t) < tl ? (t) : tl)
    AT_LOADK(Ka, t0); AT_LOADV(Va, t0); AT_LOADK(Kb, t0 + 1); AT_LOADV(Vb, t0);
    AT_QK(Sx, Ka, 0);
    { const bf16x8 z = {0, 0, 0, 0, 0, 0, 0, 0}; P0a = z; P0b = z; P1a = z; P1b = z; }
    if constexpr (NMAP == 1) {
        AT_LOADK(Ka, AT_CL(t0 + 2));
        for (int t = t0; t < t1; t += 2) {
            AT_QK(Sy, Kb, 0); AT_LOADK(Kb, AT_CL(t + 3));
            AT_PV(P1a, P1b, Vb, 0); AT_LOADV(Vb, t + 1);
            AT_SOFTMAX(Sx, 0, P0a, P0b);
            AT_QK(Sx, Ka, 0); AT_LOADK(Ka, AT_CL(t + 4));
            AT_PV(P0a, P0b, Va, 0); AT_LOADV(Va, AT_CL(t + 2));
            AT_SOFTMAX(Sy, 0, P1a, P1b);
        }
        AT_PV(P1a, P1b, Vb, 0);
    } else {
        for (int t = t0; t < t1; t += 2) {
            AT_QK(Sy, Ka, 1); AT_LOADK(Ka, AT_CL(t + 2));
            AT_PV(P0a, P0b, Va, 0); AT_PV(P1a, P1b, Va, 1); AT_LOADV(Va, t);
            AT_SOFTMAX(Sx, 0, P0a, P0b);
            AT_QK(Sx, Kb, 0);
            AT_SOFTMAX(Sy, 1, P1a, P1b);
            AT_QK(Sy, Kb, 1); AT_LOADK(Kb, AT_CL(t + 3));
            AT_PV(P0a, P0b, Va, 0); AT_PV(P1a, P1b, Va, 1); AT_LOADV(Va, t + 1);
            AT_SOFTMAX(Sx, 0, P0a, P0b);
            AT_QK(Sx, Ka, 0);
            AT_SOFTMAX(Sy, 1, P1a, P1b);
        }
        AT_PV(P0a, P0b, Va, 0); AT_PV(P1a, P1b, Va, 1);
    }
#undef AT_LOADK
#undef AT_LOADV
#undef AT_QK
#undef AT_PV
#undef AT_SOFTMAX
#undef AT_CL
}

template <int DQK, int NMAP>
DI void attn_core_staged(const bf16_t* Q, int ldq, int rope_pos0, const bf16_t* K, size_t kmapstride, const bf16_t* VT, int half, int ntile, float cs, f32x16 (&o)[NMAP][2], float (&mrun)[NMAP], float (&lrun)[NMAP],
                         int lane, int wave, LAS unsigned char* ring) {
    constexpr int NS = DQK / 16;
    const int r = lane & 31, h = lane >> 5;
    bf16x8 qf[NMAP][NS];
#pragma unroll
    for (int mp = 0; mp < NMAP; ++mp)
#pragma unroll
        for (int s = 0; s < NS; ++s) qf[mp][s] = *(const bf16x8*)(Q + (size_t)r * ldq + mp * 32 + 16 * s + 8 * h);
    if (NMAP == 2 && rope_pos0 >= 0) {
        const int pos = (rope_pos0 + r) & 2047;
        const float fa = (float)(h ? (pos & 63) : (pos >> 6));
#pragma unroll
        for (int mp = 0; mp < NMAP; ++mp) {
            float x1[8], x2[8];
            unpack8(__builtin_bit_cast(u32x4, qf[mp][0]), x1); unpack8(__builtin_bit_cast(u32x4, qf[mp][1]), x2);
#pragma unroll
            for (int jj = 0; jj < 8; ++jj) {
                const float inv = exp2f(-(float)jj * (13.287712379549449f / 8.f));
                const float ang = fa * inv, c = __cosf(ang), sn = __sinf(ang);
                const float a = x1[jj], b = x2[jj];
                x1[jj] = a * c - b * sn; x2[jj] = a * sn + b * c;
            }
            qf[mp][0] = __builtin_bit_cast(bf16x8, pack8(x1)); qf[mp][1] = __builtin_bit_cast(bf16x8, pack8(x2));
        }
    }
#pragma unroll
    for (int mp = 0; mp < NMAP; ++mp) { mrun[mp] = -1e30f; lrun[mp] = 0.f;
#pragma unroll
        for (int i = 0; i < 16; ++i) { o[mp][0][i] = 0.f; o[mp][1][i] = 0.f; } }
    const char* src[2]; size_t tstride[2];
#pragma unroll
    for (int j = 0; j < 2; ++j) { const int pc = 2 * wave + j, hh = pc >> 3, q = pc & 7;
        if (q < 4) { const int mp = NMAP == 1 ? 0 : (q >> 1), sx = NMAP == 1 ? q : (q & 1);
            src[j] = (const char*)K + ((size_t)mp * kmapstride + (size_t)((hh * ntile) * NS + sx) * 512) * 2 + lane * 16; tstride[j] = (size_t)NS * 1024; }
        else { src[j] = (const char*)VT + (size_t)(((hh * ntile) * 2 + ((q - 4) >> 1)) * 2 + ((q - 4) & 1)) * 1024 + lane * 16; tstride[j] = 4096; } }
#define AS_ISSUE(t) do { _Pragma("unroll") for (int j_ = 0; j_ < 2; ++j_) \
        __builtin_amdgcn_global_load_lds((const unsigned*)(src[j_] + (size_t)(t) * tstride[j_]), (LAS unsigned*)(ring + ((t) & 3) * 16384 + (2 * wave + j_) * 1024), 16, 0, 0); } while (0)
    asm volatile("s_waitcnt vmcnt(0)" ::: "memory");
    AS_ISSUE(0); AS_ISSUE(1); AS_ISSUE(2);
    for (int t = 0; t < ntile; ++t) {
        asm volatile("s_waitcnt vmcnt(4)" ::: "memory");
        __builtin_amdgcn_s_barrier();
        AS_ISSUE(t + 3);
        const LAS unsigned char* sl = ring + (t & 3) * 16384 + half * 8192 + lane * 16;
        bf16x8 kf[NMAP][NS], vf[2][2];
#pragma unroll
        for (int mp = 0; mp < NMAP; ++mp)
#pragma unroll
            for (int s = 0; s < NS; ++s) kf[mp][s] = *(const LAS bf16x8*)(sl + (mp * NS + s) * 1024);
#pragma unroll
        for (int mt = 0; mt < 2; ++mt)
#pragma unroll
            for (int sp = 0; sp < 2; ++sp) vf[mt][sp] = *(const LAS bf16x8*)(sl + 4096 + (mt * 2 + sp) * 1024);
#pragma unroll
        for (int mp = 0; mp < NMAP; ++mp) {
            f32x16 S;
#pragma unroll
            for (int i = 0; i < 16; ++i) S[i] = 0.f;
#pragma unroll
            for (int s = 0; s < NS; ++s) S = MFMA32(kf[mp][s], qf[mp][s], S);
            float mx = fmaxf(fmaxf(S[0], S[1]), fmaxf(S[2], S[3]));
#pragma unroll
            for (int i = 4; i < 16; i += 4) mx = fmaxf(mx, fmaxf(fmaxf(S[i], S[i + 1]), fmaxf(S[i + 2], S[i + 3])));
            { const auto sw_ = __builtin_amdgcn_permlane32_swap(__builtin_bit_cast(unsigned, mx), __builtin_bit_cast(unsigned, mx), false, false);
              mx = fmaxf(__builtin_bit_cast(float, sw_[0]), __builtin_bit_cast(float, sw_[1])); }
            if (__builtin_amdgcn_ballot_w64(mx > mrun[mp]) != 0ull) {
                const float mn = fmaxf(mrun[mp], mx);
                const float alpha = __builtin_amdgcn_exp2f((mrun[mp] - mn) * cs);
                mrun[mp] = mn; lrun[mp] *= alpha;
                o[mp][0] *= alpha; o[mp][1] *= alpha;
            }
            const float nb = mrun[mp] * cs;
            float ps = 0.f; bf16x8 pa, pb;
            { float pv[8];
#pragma unroll
              for (int i = 0; i < 8; ++i) { pv[i] = __builtin_amdgcn_exp2f(S[i] * cs - nb); ps += pv[i]; } pa = __builtin_bit_cast(bf16x8, pack8(pv)); }
            { float pv[8];
#pragma unroll
              for (int i = 0; i < 8; ++i) { pv[i] = __builtin_amdgcn_exp2f(S[8 + i] * cs - nb); ps += pv[i]; } pb = __builtin_bit_cast(bf16x8, pack8(pv)); }
            lrun[mp] += ps;
#pragma unroll
            for (int mt = 0; mt < 2; ++mt) { o[mp][mt] = MFMA32(vf[mt][0], pa, o[mp][mt]); o[mp][mt] = MFMA32(vf[mt][1], pb, o[mp][mt]); }
        }
    }
    asm volatile("s_waitcnt vmcnt(0)" ::: "memory");
    __builtin_amdgcn_s_barrier();
#undef AS_ISSUE
}

template <int TYPE>
DI void attn_item(const Params& p, int l, int lat, int b, int head, int qt, int part, int nparts, LAS float* xch, bool combine, int lane, int wave, LAS unsigned char* lds) {
    constexpr int NMAP = TYPE == 0 ? 1 : 2;
    constexpr int DQK = TYPE == 0 ? 64 : 32;
    unsigned char* ws = p.ws;
    unsigned char* att = ws + WS_ATT;
    bf16_t* br = (bf16_t*)(ws + WS_BR);
    const int r = lane & 31, h = lane >> 5;
    const int token0 = (lat ? TC + b * 2048 : b * 256) + qt * 32;
    const int nkeys = lat ? 2560 : 256;
    const int kb = part * (nkeys / nparts), ke = kb + nkeys / nparts;
    const bf16_t *Q, *K, *VT; size_t kms = 0; float cs; int ldq = 256, rope0 = -1;
    if (TYPE == 0) {
        const int hk = head >> 1;
        Q = (const bf16_t*)(att + A_QB) + (size_t)token0 * 256 + head * 64;
        K = lat ? (const bf16_t*)(att + A_KBL) + (size_t)(b * 2 + hk) * 2560 * 64 : (const bf16_t*)(att + A_KBC) + (size_t)(b * 2 + hk) * 256 * 64;
        VT = lat ? (const bf16_t*)(att + A_VBL) + (size_t)(b * 2 + hk) * 64 * 2560 : (const bf16_t*)(att + A_VBC) + (size_t)(b * 2 + hk) * 64 * 256;
        cs = 0.125f * 1.4426950408889634f;
    } else {
        Q = (const bf16_t*)(ws + WS_PROJ) + (size_t)token0 * NPROJ + 512 + head * 64; ldq = NPROJ;
        if (lat) rope0 = (token0 - TC) & 2047;
        K = lat ? (const bf16_t*)(att + A_KCL) + (size_t)(b * 8 + head * 2) * 2560 * 32 : (const bf16_t*)(att + A_KCC) + (size_t)(b * 8 + head * 2) * 256 * 32;
        VT = lat ? (const bf16_t*)(att + A_VCL) + (size_t)(b * 4 + head) * 64 * 2560 : (const bf16_t*)(att + A_VCC) + (size_t)(b * 4 + head) * 64 * 256;
        kms = (size_t)nkeys * 32; cs = 0.17677669529663687f * 1.4426950408889634f;
    }
    f32x16 o[NMAP][2]; float mr[NMAP], lr[NMAP];
    if (combine) attn_core_staged<DQK, NMAP>(Q, ldq, rope0, K, kms, VT, part, nkeys / (32 * nparts), cs, o, mr, lr, lane, wave, lds);
    else attn_core<DQK, NMAP>(Q, ldq, K, kms, VT, kb, ke, cs, o, mr, lr, lane);
    if (combine) {
        if (part == 1) {
#pragma unroll
            for (int mp = 0; mp < NMAP; ++mp) {
#pragma unroll
                for (int mt = 0; mt < 2; ++mt)
#pragma unroll
                    for (int i = 0; i < 16; ++i) xch[((mp * 2 + mt) * 16 + i) * 64 + lane] = o[mp][mt][i];
                xch[(64 + mp * 2) * 64 + lane] = mr[mp]; xch[(65 + mp * 2) * 64 + lane] = lr[mp];
            }
        }
        __syncthreads();
        if (part == 1) return;
#pragma unroll
        for (int mp = 0; mp < NMAP; ++mp) {
            const float m2 = xch[(64 + mp * 2) * 64 + lane], l2 = xch[(65 + mp * 2) * 64 + lane];
            const float mn = fmaxf(mr[mp], m2), a1 = __builtin_amdgcn_exp2f((mr[mp] - mn) * cs), a2 = __builtin_amdgcn_exp2f((m2 - mn) * cs);
            lr[mp] = lr[mp] * a1 + l2 * a2;
#pragma unroll
            for (int mt = 0; mt < 2; ++mt)
#pragma unroll
                for (int i = 0; i < 16; ++i) o[mp][mt][i] = o[mp][mt][i] * a1 + xch[((mp * 2 + mt) * 16 + i) * 64 + lane] * a2;
        }
    }
    float ls[NMAP];
#pragma unroll
    for (int mp = 0; mp < NMAP; ++mp) ls[mp] = lr[mp] + __shfl_xor(lr[mp], 32);
    if (TYPE == 0) {
        const float inv = 1.f / ls[0];
        bf16_t* dst = br + (size_t)(token0 + r) * 1280 + 512 + head * 64;
#pragma unroll
        for (int mt = 0; mt < 2; ++mt)
#pragma unroll
            for (int g4 = 0; g4 < 4; ++g4) { u32x2 w; w.x = cvtpk(o[0][mt][4 * g4] * inv, o[0][mt][4 * g4 + 1] * inv); w.y = cvtpk(o[0][mt][4 * g4 + 2] * inv, o[0][mt][4 * g4 + 3] * inv);
                *(u32x2*)(dst + 32 * mt + 8 * g4 + 4 * h) = w; }
    } else {
        const float lam = ((const float*)(ws + CTL_LAM))[l];
        const float lam_scale = 1.f - (0.8f - 0.6f * expf(-0.3f * (float)l));
        const float i0 = 1.f / ls[0], i1 = lam / ls[NMAP - 1];
        float ss = 0.f;
#pragma unroll
        for (int mt = 0; mt < 2; ++mt)
#pragma unroll
            for (int i = 0; i < 16; ++i) { const float v = o[0][mt][i] * i0 - o[NMAP - 1][mt][i] * i1; o[0][mt][i] = v; ss += v * v; }
        ss += __shfl_xor(ss, 32);
        const float rn = rsqrtf(ss * (1.f / 64.f) + EPS) * lam_scale;
        const float* dg = p.in[20] + l * 64;
        bf16_t* dst = br + (size_t)(token0 + r) * 1280 + 768 + head * 64;
#pragma unroll
        for (int mt = 0; mt < 2; ++mt)
#pragma unroll
            for (int g4 = 0; g4 < 4; ++g4) { const int d0 = 32 * mt + 8 * g4 + 4 * h; const f32x4 g = *(const f32x4*)(dg + d0);
                u32x2 w; w.x = cvtpk(o[0][mt][4 * g4] * rn * g[0], o[0][mt][4 * g4 + 1] * rn * g[1]); w.y = cvtpk(o[0][mt][4 * g4 + 2] * rn * g[2], o[0][mt][4 * g4 + 3] * rn * g[3]);
                *(u32x2*)(dst + d0) = w; }
    }
}

DI void attn_phase(const Params& p, int l, LAS unsigned char* lds) {
    const int tid_ = opaque_v(TIDX), lane = tid_ & 63, wave = __builtin_amdgcn_readfirstlane(tid_ >> 6);
    const int bx = blockIdx.x;
    const int bb = bx - 32;
    LAS float* xch = (LAS float*)lds + (wave & 3) * (68 * 64);
    { int n0 = -1, nstep = 0, ncnt = 0;
      if (bx < 32) { n0 = bx * 8 + wave; nstep = 256; ncnt = 2; }
      else if (bb >= 160) { n0 = 512 + (bb - 160) * 8 + wave; nstep = 512; ncnt = 3; }
      if (bx < 32) {
        for (int j = 0; j < ncnt; ++j) { const int n = n0 + j * nstep, i2 = (n & 1) ? 1024 + (n >> 1) : (n >> 1);
            const int type = i2 >> 10, rem = i2 & 1023, b = rem >> 5, head = (rem >> 3) & 3, qt = rem & 7;
            if (type == 0) attn_item<0>(p, l, 0, b, head, qt, 0, 1, xch, false, lane, wave, lds);
            else attn_item<1>(p, l, 0, b, head, qt, 0, 1, xch, false, lane, wave, lds); }
        return;
      }
    }
    for (int round = 0; round < 2; ++round) {
        if (round == 1 && (bb < 128 || bb >= 160)) break;
        const int q = bb * 4 + (wave & 3);
        int type, ii;
        if (round == 0) { type = q < 512 ? 1 : 0; ii = q < 512 ? q : q - 512; }
        else { type = 0; ii = 384 + (bb - 128) * 4 + (wave & 3); }
        const int b = ii >> 8, head = (ii >> 6) & 3, qt = ii & 63;
        if (type == 0) attn_item<0>(p, l, 1, b, head, qt, wave >> 2, 2, xch, true, lane, wave, lds);
        else attn_item<1>(p, l, 1, b, head, qt, wave >> 2, 2, xch, true, lane, wave, lds);
        __syncthreads();
    }
    if (bb >= 160)
    for (int j = 0; j < 3; ++j) { const int n = 512 + (bb - 160) * 8 + wave + j * 512, i2 = (n & 1) ? 1024 + (n >> 1) : (n >> 1);
        const int type = i2 >> 10, rem = i2 & 1023, b = rem >> 5, head = (rem >> 3) & 3, qt = rem & 7;
        if (type == 0) attn_item<0>(p, l, 0, b, head, qt, 0, 1, xch, false, lane, wave, lds);
        else attn_item<1>(p, l, 0, b, head, qt, 0, 1, xch, false, lane, wave, lds);
    }
}

#define XB_TMO      128
#define XB_XCNT(j)  (256  + 64 * (j))
#define XB_XSUB(j)  (1280 + 64 * (j))
#define XB_XGEN(j)  (2304 + 64 * (j))
#define XB_TOP      3328
#define XB_TOPGEN   3392
#define XCD_BAR_WORDS 3456
#define XB_SPIN_CAP (1u << 20)
DI unsigned xb_ld(unsigned* p)              { return __hip_atomic_load(p, __ATOMIC_RELAXED, __HIP_MEMORY_SCOPE_AGENT); }
DI unsigned xb_add(unsigned* p, unsigned v) { return __hip_atomic_fetch_add(p, v, __ATOMIC_RELAXED, __HIP_MEMORY_SCOPE_AGENT); }
DI unsigned xb_xcc_id() { return (unsigned)__builtin_amdgcn_s_getreg((3 << 11) | 20) & 0xFu; }
#define XB_SPIN(cond, bar) do { unsigned _sp = 0; while (cond) { __builtin_amdgcn_s_sleep(1); \
    if ((++_sp & 255u) == 0u) { if (xb_ld(&(bar)[XB_TMO])) break; if (_sp > XB_SPIN_CAP) { atomicAdd(&(bar)[XB_TMO], 1u); break; } } } } while (0)
struct XcdBarrier { unsigned* bar; unsigned x; volatile LAS unsigned* st; };
DI XcdBarrier xcd_barrier_post(unsigned* bar, volatile LAS unsigned* st) {
    XcdBarrier b; b.bar = bar; b.x = xb_xcc_id(); b.st = st;
    if (TIDX == 0) (void)xb_add(&bar[XB_XCNT(b.x)], 1u);
    return b;
}
DI void xcd_barrier_complete(unsigned* bar, unsigned x, unsigned& nloc, unsigned& nx) {
    const unsigned G = gridDim.x * gridDim.y * gridDim.z;
    unsigned sum, cnt, mine, sp = 0u;
    for (;;) {
        sum = 0u; cnt = 0u; mine = 0u;
#pragma unroll
        for (unsigned j = 0; j < 16; ++j) { const unsigned c = xb_ld(&bar[XB_XCNT(j)]); sum += c; cnt += (c > 0u) ? 1u : 0u; mine = (j == x) ? c : mine; }
        if (sum == G) break;
        __builtin_amdgcn_s_sleep(1);
        if ((++sp & 255u) == 0u) { if (xb_ld(&bar[XB_TMO])) break; if (sp > XB_SPIN_CAP) { atomicAdd(&bar[XB_TMO], 1u); break; } }
    }
    nloc = mine > 0u ? mine : 1u; nx = cnt > 0u ? cnt : 1u;
}
DI void xcd_barrier(const XcdBarrier& b) {
    asm volatile("s_waitcnt vmcnt(0)" ::: "memory");
    __syncthreads();
    if (TIDX == 0) {
        unsigned* bar = b.bar;
        __builtin_amdgcn_s_waitcnt(0);
        unsigned nloc = b.st[0], nx = b.st[1];
        if (nloc == 0u) { xcd_barrier_complete(bar, b.x, nloc, nx); b.st[0] = nloc; b.st[1] = nx; }
        const unsigned old = xb_add(&bar[XB_XSUB(b.x)], 1u);
        const unsigned gen = old / nloc;
        if (old + 1u == (gen + 1u) * nloc) {
            __builtin_amdgcn_fence(__ATOMIC_RELEASE, "agent");
            asm volatile("s_waitcnt vmcnt(0)" ::: "memory");
            const unsigned og = xb_add(&bar[XB_TOP], 1u);
            const unsigned tg = og / nx;
            if (og + 1u == (tg + 1u) * nx) xb_add(&bar[XB_TOPGEN], 1u);
            else XB_SPIN(xb_ld(&bar[XB_TOPGEN]) == tg, bar);
            __builtin_amdgcn_fence(__ATOMIC_ACQUIRE, "agent");
            xb_add(&bar[XB_XGEN(b.x)], 1u);
            asm volatile("s_waitcnt vmcnt(0)" ::: "memory");
        } else {
            XB_SPIN(xb_ld(&bar[XB_XGEN(b.x)]) == gen, bar);
            __builtin_amdgcn_fence(__ATOMIC_ACQUIRE, "agent");
            asm volatile("s_waitcnt vmcnt(0)" ::: "memory");
        }
    }
    __syncthreads();
}

__global__ void __launch_bounds__(NWAVES * 64, 2) mega_fwd(Params p) {
    extern __shared__ __attribute__((aligned(16))) unsigned char lds_raw[];
    LAS unsigned char* lds = (LAS unsigned char*)lds_raw;
    cg::grid_group grid = cg::this_grid();
    const int G = gridDim.x, bx = blockIdx.x;
    unsigned char* ws = p.ws;

    { const unsigned hw_ = (unsigned)__builtin_amdgcn_s_getreg((5 << 11) | 4) & 63u; ((volatile LAS int*)(131072 + 64))[hw_] = (int)(__builtin_amdgcn_workitem_id_x() >> 6); }
    __syncthreads();
    volatile LAS unsigned* bst = (volatile LAS unsigned*)(lds + 131072);
    if (TIDX == 0) { bst[0] = 0u; bst[1] = 0u; }
    if (bx == 0 && TIDX < 64) for (int i = TIDX; i < 8192; i += 64) ((unsigned*)(ws + CTL_BAR))[i] = 0u;
    asm volatile("s_waitcnt vmcnt(0)" ::: "memory");
    grid.sync();
    (void)xcd_barrier_post((unsigned*)(ws + CTL_BAR), bst);
#define XBAR() do { XcdBarrier xb_; xb_.bar = (unsigned*)(p.ws + CTL_BAR); xb_.x = xb_xcc_id(); xb_.st = (volatile LAS unsigned*)(lds + 131072); xcd_barrier(xb_); } while (0)
    prologue(p, lds, 0, 4, bx, G, true);
    XBAR();
    for (int st = 0; st < 36; ++st) {
        const int l = st / 9, k = st % 9;
        if (k == 0 || k == 6) norm_phase(p, l, k == 0 ? 0 : 1);
        else if (k == 2) pp_phase(p, l);
        else {
            const int j0 = k == 1 ? J_G1A : k == 3 ? J_DFTL : k == 4 ? J_G2 : k == 5 ? J_G3 : k == 7 ? J_G4 : J_G5;
            const int j1 = k == 1 ? J_G1B : k == 3 ? J_SGU : j0;
            unsigned char* wl = ws + WS_W + (size_t)l * W_LAYER;
            for (int job = j0; job <= j1; ++job) {
                Sched S; S.job = job; S.G = G; S.c = bx; S.nM = 48; S.nN = 4; S.nt = 16; S.lda = 1024; S.ldb = 1024;
                switch (job) {
                case J_G1A: S.A = (const char*)(ws + WS_H); S.B = (const char*)(wl + W_CAT); S.nN = 23; break;
                case J_G1B: S.A = (const char*)(wl + W_A); S.B = (const char*)(ws + WS_H); S.nM = 2; S.nN = 48; S.c = (bx - 80 + G) % G; break;
                case J_DFTL: S.A = (const char*)(ws + WS_FLAT); S.B = (const char*)(ws + WS_ZTL); S.lda = 4096; S.ldb = 4096; S.nM = 16; S.nN = 2; break;
                case J_DFTC: S.A = (const char*)(ws + WS_FCTX); S.B = (const char*)(ws + WS_ZTC); S.lda = 512; S.ldb = 512; S.nM = 32; S.nN = 2; S.c = (bx - 32 + G) % G; break;
                case J_SGU: S.A = (const char*)(wl + W_SP); S.B = (const char*)(ws + WS_DVT); S.lda = 256; S.ldb = 256; S.nM = 2; S.nN = 24; S.c = (bx - 96 + G) % G; break;
                case J_G2: S.A = (const char*)(ws + WS_BR); S.B = (const char*)(wl + W_BALL); S.lda = 1280; S.ldb = 1280; break;
                case J_G3: S.A = (const char*)(ws + WS_MERGED); S.B = (const char*)(wl + W_OUT); break;
                case J_G4: S.A = (const char*)(ws + WS_H); S.B = (const char*)(wl + W_1); S.nN = 16; break;
                default: S.A = (const char*)(ws + WS_GATES); S.B = (const char*)(wl + W_2); S.lda = 4096; S.ldb = 4096; S.nt = 64; break;
                }
                S.nwg = S.nM * S.nN;
                const Epi E{job, l, p};
                pg8::gemm_phase<Epi, Sched>(lds, S.lda, S.ldb, S, E);
            }
            if (k == 3) attn_phase(p, l, lds);
        }
        XBAR();
    }
    norm_phase(p, 0, 2);
}

extern "C" void kernel_launch(void* const* d_in, const int* in_sizes, int n_in, void* d_out, int out_size, void* d_ws, size_t ws_size, hipStream_t stream) {
    static int grid = 0;
    constexpr int LDS_BYTES = 131072 + 1024;
    if (grid == 0) {
        if (n_in != 30 || ws_size < WS_END) { fprintf(stderr, "kernel_launch: n_in %d ws %zu (need %zu)\n", n_in, ws_size, (size_t)WS_END); grid = -1; return; }
        int dev = 0, cus = 0, per_cu = 0;
        (void)hipGetDevice(&dev);
        (void)hipDeviceGetAttribute(&cus, hipDeviceAttributeMultiprocessorCount, dev);
        (void)hipFuncSetAttribute((const void*)mega_fwd, hipFuncAttributeMaxDynamicSharedMemorySize, LDS_BYTES);
        (void)hipOccupancyMaxActiveBlocksPerMultiprocessor(&per_cu, (const void*)mega_fwd, NWAVES * 64, LDS_BYTES);
        if (per_cu < 1) per_cu = 1;
        grid = cus;
        (void)hipGetLastError();
    }
    if (grid < 0) return;
    Params prm{};
    for (int i = 0; i < 30; ++i) prm.in[i] = (const float*)d_in[i];
    prm.out = (float*)d_out; prm.ws = (unsigned char*)d_ws;
    void* args[] = {&prm};
    hipError_t e = hipLaunchCooperativeKernel((const void*)mega_fwd, dim3(grid), dim3(NWAVES * 64), args, LDS_BYTES, stream);
    if (e != hipSuccess) fprintf(stderr, "cooperative launch failed: %s (grid %d)\n", hipGetErrorString(e), grid);
}
```

```cpp
#include <hip/hip_runtime.h>
#include <hip/hip_cooperative_groups.h>
#include <cstdio>
#include <cstdint>
namespace cg = cooperative_groups;

#define LAS __attribute__((address_space(3)))
#define DI __device__ __forceinline__
typedef unsigned short bf16_t;
typedef short bf16x8 __attribute__((ext_vector_type(8)));
typedef short s16x4 __attribute__((ext_vector_type(4)));
typedef float f32x4 __attribute__((ext_vector_type(4)));
typedef float f32x16 __attribute__((ext_vector_type(16)));
typedef unsigned u32x4 __attribute__((ext_vector_type(4)));
typedef unsigned u32x2 __attribute__((ext_vector_type(2)));
typedef __bf16 bf16x2_t __attribute__((ext_vector_type(2)));
typedef float f32x2_t __attribute__((ext_vector_type(2)));

constexpr int T = 12288, TC = 8192, DM = 1024, NPROJ = 1792;
constexpr int NWAVES = 8;
constexpr float EPS = 1e-6f;

constexpr size_t MiB = 1u << 20;
constexpr size_t CTL_BYTES = 1 * MiB;
constexpr size_t CTL_CTR = 0;
constexpr size_t CTL_MOD = 65536;
constexpr size_t CTL_LAM = CTL_MOD + 294912;
constexpr size_t CTL_FLAG = 524288 + 16384;
constexpr size_t CTL_BAR = 524288;
constexpr size_t WS_W = 1 * MiB;
constexpr size_t W_CAT = 0, W_A = W_CAT + 12058624, W_BALL = W_A + 1048576, W_OUT = W_BALL + 2621440, W_1 = W_OUT + 2097152,
                 W_2 = W_1 + 8388608, W_SP = W_2 + 8388608, W_LAYER = W_SP + 262144;
constexpr size_t WS_FCTX = WS_W + 4 * W_LAYER;
constexpr size_t WS_FLAT = WS_FCTX + 262144;
constexpr size_t WS_GATES = WS_FLAT + 16777216;
constexpr size_t WS_H = WS_GATES + 100663296;
constexpr size_t WS_PROJ = WS_H + 25165824;
constexpr size_t WS_S = WS_H;
constexpr size_t WS_BR = WS_PROJ + 44040192;
constexpr size_t WS_ZTC = WS_BR + 31457280;
constexpr size_t WS_ZTL = WS_ZTC + 8388608;
constexpr size_t WS_ATT = WS_ZTL + 4194304;
constexpr size_t A_QB = 0, A_KBC = 6291456, A_KBL = 8388608, A_VBC = 9699328, A_VBL = 11796480, A_QC = 13107200, A_KCC = 19398656,
                 A_KCL = 23592960, A_VCC = 26214400, A_VCL = 30408704, A_END = 33030144;
constexpr size_t WS_MERGED = WS_ATT;
constexpr size_t WS_DVT = WS_ATT + A_END;
constexpr size_t WS_END = WS_DVT + 6291456;
static_assert(WS_S + 50331648 <= WS_BR, "S overlay");
static_assert(25165824 <= A_END, "merged overlay");

constexpr size_t O_GK = 12582912, O_GV = 16777216, O_DK = 20971520, O_DV = 29360128;

struct Params { const float* in[30]; float* out; unsigned char* ws; };

DI unsigned cvtpk(float lo, float hi) { f32x2_t v = {lo, hi}; bf16x2_t b = __builtin_convertvector(v, bf16x2_t); return __builtin_bit_cast(unsigned, b); }
DI float bflo(unsigned u) { return __builtin_bit_cast(float, u << 16); }
DI float bfhi(unsigned u) { return __builtin_bit_cast(float, u & 0xffff0000u); }
DI void unpack8(u32x4 w, float* f) { f[0] = bflo(w.x); f[1] = bfhi(w.x); f[2] = bflo(w.y); f[3] = bfhi(w.y); f[4] = bflo(w.z); f[5] = bfhi(w.z); f[6] = bflo(w.w); f[7] = bfhi(w.w); }
DI u32x4 pack8(const float* f) { u32x4 w; w.x = cvtpk(f[0], f[1]); w.y = cvtpk(f[2], f[3]); w.z = cvtpk(f[4], f[5]); w.w = cvtpk(f[6], f[7]); return w; }
DI float sigmoidf_(float v) { return __builtin_amdgcn_rcpf(1.f + __expf(-v)); }
DI float gelu_tanh(float v) { return v * sigmoidf_(1.5957691216057308f * (v + 0.044715f * v * v * v)); }
DI int fast_tid() {
    const unsigned hw = (unsigned)__builtin_amdgcn_s_getreg((5 << 11) | 4) & 63u;
    const int wv = ((const volatile LAS int*)(131072 + 64))[hw];
    return __builtin_amdgcn_readfirstlane(wv) * 64 + (int)__builtin_amdgcn_mbcnt_hi(~0u, __builtin_amdgcn_mbcnt_lo(~0u, 0u));
}
#define TIDX fast_tid()
DI int opaque_v(int x) { asm volatile("" : "+v"(x)); return x; }
DI float wave_sum(float v) {
#pragma unroll
    for (int o = 1; o < 64; o <<= 1) v += __shfl_xor(v, o);
    return v;
}

namespace pg8 {
constexpr int BM = 256, BK = 64, HALF = 128, HTB = HALF * BK * 2, STAGE_BYTES = 8 * HTB;
DI int lds_byte(int r, int c) { const int st = (r >> 4) * 2 + (c >> 5), rr = r & 15, cc = c & 31, ob = rr * 64 + cc * 2; return st * 1024 + (ob ^ (((ob >> 9) & 1) << 5)); }
DI void stage_rc(int b, int& R, int& C) { const int st = b / 1024, sb = b % 1024, swz = sb ^ (((sb >> 9) & 1) << 5); R = (st >> 1) * 16 + swz / 64; C = (st & 1) * 32 + (swz % 64) / 2; }
DI int perm32(int rho) { const int n = rho >> 4, i = rho & 15; return 8 * (i >> 2) + 4 * n + (i & 3); }

struct Unit { const char* A; const char* B; int nt, r0, c0, z, keep; };

template <class Epi, class Sched>
DI void gemm_phase(LAS unsigned char* lds, const int lda, const int ldb, const Sched& S, const Epi& E) {
    const int tid = opaque_v(TIDX), wid = __builtin_amdgcn_readfirstlane(tid >> 6), lane = tid & 63, wr = wid >> 2, wc = wid & 3, fr = lane & 15, fq = lane >> 4;
    unsigned voffA[2], voffB[2];
#pragma unroll
    for (int i = 0; i < 2; ++i) { int R, C; stage_rc(tid * 16 + i * 8192, R, C); const int Rb = (R & ~31) + perm32(R & 31);
        voffA[i] = (unsigned)(R * lda + C) * 2u; voffB[i] = (unsigned)(Rb * ldb + C) * 2u; }
    const size_t kstep = (size_t)(BK * 2);
    const size_t hstepA = (size_t)HALF * lda * 2, hstepB = (size_t)HALF * ldb * 2;
    const unsigned ldsw = (unsigned)wid * 1024u;
    const int aoff = lds_byte(wr * 64 + fr, fq * 8), boff = lds_byte(wc * 32 + fr, fq * 8);
#define PG8_SA(b, h) (((b) * 2 + (h)) * HTB)
#define PG8_SB(b, h) ((4 + (b) * 2 + (h)) * HTB)
#define PG8_STAGE(bufoff, gbase, voff) do { _Pragma("unroll") for (int _i = 0; _i < 2; ++_i) \
        __builtin_amdgcn_global_load_lds((const unsigned*)((const char*)(gbase) + (voff)[_i]), (LAS unsigned*)(lds + (bufoff) + ldsw + _i * 8192), 16, 0, 0); } while (0)
#define PG8_LDA(dst, b, h) do { _Pragma("unroll") for (int m = 0; m < 4; ++m) _Pragma("unroll") for (int k = 0; k < 2; ++k) dst[m][k] = *(const LAS bf16x8*)(lds + PG8_SA(b, h) + aoff + m * 2048 + k * 1024); } while (0)
#define PG8_LDB(dst, b, h) do { _Pragma("unroll") for (int n = 0; n < 2; ++n) _Pragma("unroll") for (int k = 0; k < 2; ++k) dst[n][k] = *(const LAS bf16x8*)(lds + PG8_SB(b, h) + boff + n * 2048 + k * 1024); } while (0)
#define PG8_MMA(ai, bj, At, Bt) do { __builtin_amdgcn_s_setprio(1); _Pragma("unroll") for (int m = 0; m < 4; ++m) _Pragma("unroll") for (int n = 0; n < 2; ++n) _Pragma("unroll") for (int k = 0; k < 2; ++k) \
        acc[ai][bj][m][n] = __builtin_amdgcn_mfma_f32_16x16x32_bf16(Bt[n][k], At[m][k], acc[ai][bj][m][n], 0, 0, 0); __builtin_amdgcn_s_setprio(0); } while (0)
#define PG8_WAIT_V(n) asm volatile("s_waitcnt vmcnt(" #n ")" ::: "memory")
#define PG8_WAIT_L(n) asm volatile("s_waitcnt lgkmcnt(" #n ")" ::: "memory")
#define PG8_BAR __builtin_amdgcn_s_barrier()
#define PG8_SCHED __builtin_amdgcn_sched_barrier(0)
    Unit cur, nxt; int ui = 0;
    if (!S.next(0, cur)) return;
    f32x4 acc[2][2][4][2];
#pragma unroll
    for (int a = 0; a < 2; ++a)
#pragma unroll
        for (int b = 0; b < 2; ++b)
#pragma unroll
            for (int m = 0; m < 4; ++m)
#pragma unroll
                for (int n = 0; n < 2; ++n) acc[a][b][m][n] = (f32x4){0.f, 0.f, 0.f, 0.f};
    bf16x8 At[4][2], B0[2][2], B1[2][2];
    const char* cA = cur.A; const char* cB = cur.B;
    PG8_STAGE(PG8_SB(0, 0), cB, voffB); PG8_STAGE(PG8_SB(0, 1), cB + hstepB, voffB); PG8_STAGE(PG8_SA(0, 0), cA, voffA); PG8_STAGE(PG8_SA(0, 1), cA + hstepA, voffA);
    if (wr == 1) PG8_BAR;
    PG8_WAIT_V(2); PG8_BAR;
    PG8_STAGE(PG8_SB(1, 0), cB + kstep, voffB); PG8_STAGE(PG8_SA(1, 0), cA + kstep, voffA); PG8_STAGE(PG8_SB(1, 1), cB + hstepB + kstep, voffB);
    PG8_WAIT_V(6); PG8_BAR;
    for (;;) {
        const bool has_next = S.next(ui + 1, nxt);
        const char* nA = has_next ? nxt.A : cA; const char* nB = has_next ? nxt.B : cB;
        const int nt = cur.nt;
        for (int t = 0; t < nt; t += 2) {
            const bool last = (t == nt - 2);
            const char* a1 = cA + (size_t)(t + 1) * kstep;
            const char* a2 = last ? nA : cA + (size_t)(t + 2) * kstep; const char* b2 = last ? nB : cB + (size_t)(t + 2) * kstep;
            const char* a3 = a2 + kstep; const char* b3 = b2 + kstep;
            PG8_LDB(B0, 0, 0); PG8_LDB(B1, 0, 1); PG8_SCHED; PG8_LDA(At, 0, 0); PG8_STAGE(PG8_SA(1, 1), a1 + hstepA, voffA);
            PG8_WAIT_V(8); PG8_WAIT_L(0); PG8_BAR; PG8_MMA(0, 0, At, B0); PG8_MMA(0, 1, At, B1); PG8_BAR; PG8_SCHED;
            PG8_LDA(At, 0, 1); PG8_STAGE(PG8_SB(0, 0), b2, voffB); PG8_STAGE(PG8_SB(0, 1), b2 + hstepB, voffB); PG8_STAGE(PG8_SA(0, 0), a2, voffA);
            PG8_WAIT_V(8); PG8_WAIT_L(0); PG8_BAR; PG8_MMA(1, 0, At, B0); PG8_MMA(1, 1, At, B1); PG8_BAR; PG8_SCHED;
            PG8_LDB(B0, 1, 0); PG8_LDB(B1, 1, 1); PG8_SCHED; PG8_LDA(At, 1, 0); PG8_STAGE(PG8_SA(0, 1), a2 + hstepA, voffA);
            PG8_WAIT_V(8); PG8_WAIT_L(0); PG8_BAR; PG8_MMA(0, 0, At, B0); PG8_MMA(0, 1, At, B1); PG8_BAR; PG8_SCHED;
            PG8_LDA(At, 1, 1); PG8_STAGE(PG8_SB(1, 0), b3, voffB); PG8_STAGE(PG8_SB(1, 1), b3 + hstepB, voffB); PG8_STAGE(PG8_SA(1, 0), a3, voffA);
            PG8_WAIT_V(8); PG8_WAIT_L(0); PG8_BAR; PG8_MMA(1, 0, At, B0); PG8_MMA(1, 1, At, B1); PG8_BAR; PG8_SCHED;
        }
        if (wr == 0) PG8_BAR;
        { const int ln_ = opaque_v(TIDX) & 63, fr_ = ln_ & 15, fq_ = ln_ >> 4;
        E.pre(acc, cur);
        E(acc, cur, wr, wc, fr_, fq_);
        if (!has_next) break;
        E.scale(acc, cur, wr, wc, fr_, fq_); }
        if (!nxt.keep) {
#pragma unroll
        for (int a = 0; a < 2; ++a)
#pragma unroll
            for (int b = 0; b < 2; ++b)
#pragma unroll
                for (int m = 0; m < 4; ++m)
#pragma unroll
                    for (int n = 0; n < 2; ++n) acc[a][b][m][n] = (f32x4){0.f, 0.f, 0.f, 0.f};
        }
        cur = nxt; cA = nA; cB = nB; ++ui;
        if (wr == 1) PG8_BAR;
    }
    PG8_WAIT_V(0);
    PG8_BAR;
#undef PG8_SA
#undef PG8_SB
#undef PG8_STAGE
#undef PG8_LDA
#undef PG8_LDB
#undef PG8_MMA
#undef PG8_WAIT_V
#undef PG8_WAIT_L
#undef PG8_BAR
#undef PG8_SCHED
}
}

enum { J_G1A = 0, J_G1B, J_DFTL, J_DFTC, J_SGU, J_G2, J_G3, J_G4, J_G5 };

DI void xcd_decode(int L, int nM, int nN, int nwg, int& pm, int& pn) {
    int wgid = L; { const int q = nwg / 8, r = nwg % 8, xcd = wgid % 8, off = wgid / 8; wgid = (xcd < r ? xcd * (q + 1) : r * (q + 1) + (xcd - r) * q) + off; }
    const int nig = 8 * nN, gid = wgid / nig, fm = gid * 8, gsz = (nM - fm) < 8 ? (nM - fm) : 8;
    pm = fm + ((wgid % nig) % gsz); pn = (wgid % nig) / gsz;
}

struct Sched {
    int job, G, c;
    const char* A; const char* B; int lda, ldb, nM, nN, nwg, nt;
    DI bool next(int i, pg8::Unit& u) const {
        if (job == J_G2) {
            if (c >= 192 || i >= 4) return false;
            int pm, pn; xcd_decode(c, 48, 4, 192, pm, pn);
            const int koff = i == 0 ? 0 : 256 + 256 * i;
            u.A = A + ((size_t)pm * 256 * 1280 + koff) * 2; u.B = B + ((size_t)pn * 256 * 1280 + koff) * 2; u.nt = i == 0 ? 8 : 4; u.r0 = pm * 256; u.c0 = pn * 256; u.z = i; u.keep = i > 0;
            return true;
        }
        const long Ll = (long)i * G + c; if (Ll >= nwg && job != J_G5) return false;
        const int L = (int)Ll;
        if (job == J_DFTL) {
            const int b = L >> 4, part = (L >> 3) & 1, pm = L & 7;
            u.A = A + ((size_t)pm * 256 * 4096 + part * 2048) * 2; u.B = B + ((size_t)b * 256 * 4096 + part * 2048) * 2; u.nt = 32;
            u.r0 = TC + b * 2048 + pm * 256; u.c0 = part * 256; u.z = 0; u.keep = 0; return true;
        }
        if (job == J_DFTC) {
            const int b = L >> 1, part = L & 1;
            u.A = A + (size_t)(part * 256) * 2; u.B = B + ((size_t)b * 256 * 512 + part * 256) * 2; u.nt = 4; u.r0 = b * 256; u.c0 = part * 256; u.z = 0; u.keep = 0; return true;
        }
        if (job == J_SGU) {
            const int pair = L / 24, pn = L % 24;
            u.A = A + (size_t)pair * 256 * 256 * 2; u.B = B + ((size_t)pair * 6144 + pn * 256) * 256 * 2; u.nt = 4; u.r0 = 0; u.c0 = pn * 256; u.z = pair; u.keep = 0; return true;
        }
        if (job == J_G5) {
            const int ntm = nt * 3 / 4, nth = nt - ntm;
            int tile, koff, ntu, z;
            if (c < 192) { if (i > 0) return false; tile = c; koff = 0; ntu = ntm; z = 0; }
            else { if (i >= 3) return false; tile = 3 * (c - 192) + i; koff = ntm * 64; ntu = nth; z = 1; }
            int pm, pn; xcd_decode(tile, 48, 4, 192, pm, pn);
            u.A = A + ((size_t)pm * 256 * lda + koff) * 2; u.B = B + ((size_t)pn * 256 * ldb + koff) * 2; u.nt = ntu; u.r0 = pm * 256; u.c0 = pn * 256; u.z = z + 2 * tile; u.keep = 0;
            return true;
        }
        int pm, pn; xcd_decode(L, nM, nN, nwg, pm, pn);
        u.A = A + (size_t)pm * 256 * lda * 2; u.B = B + (size_t)pn * 256 * ldb * 2; u.nt = nt; u.r0 = pm * 256; u.c0 = pn * 256; u.z = 0; u.keep = 0;
        return true;
    }
};

struct Epi {
    int job, l;
    const Params& p;
    DI void operator()(const f32x4 (&acc)[2][2][4][2], const pg8::Unit& u, int wr, int wc, int fr, int fq) const {
        unsigned char* ws = p.ws;
        const int rbase = u.r0 + wr * 64 + fr, cbase = u.c0 + wc * 32 + 8 * fq;
#define EPI_LOOP_AI for (int ai = 0; ai < 2; ++ai) _Pragma("unroll") for (int bj = 0; bj < 2; ++bj)
#define EPI_LOOP_MB _Pragma("unroll") for (int m = 0; m < 4; ++m)
#define EPI_SB asm volatile("" ::: "memory")
#define EPI_RC const int row = rbase + ai * 128 + m * 16, col = cbase + bj * 128; (void)row; (void)col
#define EPI_V float v[8]; _Pragma("unroll") for (int j = 0; j < 4; ++j) { v[j] = acc[ai][bj][m][0][j]; v[4 + j] = acc[ai][bj][m][1][j]; }
        switch (job) {
        case J_G1A: {
            if (u.c0 < NPROJ) {
#pragma unroll
                EPI_LOOP_AI { EPI_LOOP_MB { EPI_RC; EPI_V;
                    if (u.c0 >= 1280) {
#pragma unroll
                        for (int j = 0; j < 8; ++j) v[j] = gelu_tanh(v[j]); }
                    *(u32x4*)((bf16_t*)(ws + WS_PROJ) + (size_t)row * NPROJ + col) = pack8(v); } }
            } else {
#pragma unroll
                EPI_LOOP_AI { EPI_LOOP_MB { EPI_RC; EPI_V;
#pragma unroll
                    for (int j = 0; j < 8; ++j) v[j] = sigmoidf_(v[j]);
                    *(u32x4*)((bf16_t*)(ws + WS_GATES) + (size_t)row * 4096 + (col - NPROJ)) = pack8(v); } }
            }
        } break;
        case J_G1B: {
#pragma unroll
            EPI_LOOP_AI { EPI_LOOP_MB { EPI_RC; EPI_V;
                const int g = row >> 7, cs = (row >> 6) & 1, cp = row & 63, t = col;
                bf16_t* dst;
                if (t < TC) { const int b = t >> 8, k = t & 255; dst = (bf16_t*)(ws + WS_ZTC) + ((size_t)(b * 256 + g * 64 + cp) * 512 + cs * 256 + k); }
                else { const int tl = t - TC, b = tl >> 11, k = tl & 2047; dst = (bf16_t*)(ws + WS_ZTL) + ((size_t)(b * 256 + g * 64 + cp) * 4096 + cs * 2048 + k); }
                *(u32x4*)dst = pack8(v); } }
        } break;
        case J_DFTL: case J_DFTC: {
#pragma unroll
            EPI_LOOP_AI { EPI_LOOP_MB { EPI_RC; EPI_V; *(u32x4*)((bf16_t*)(ws + WS_BR) + (size_t)row * 1280 + col) = pack8(v); } }
        } break;
        case J_SGU: {
            const int q0 = wr * 64 + fr, ch0 = u.z * 128 + (wc & 1) * 32 + 8 * fq, tok0 = ((u.c0 >> 6) + (wc >> 1)) * 128 + q0;
            const bf16_t* dub = (const bf16_t*)(ws + WS_PROJ) + (size_t)tok0 * NPROJ + 1280 + ch0;
            bf16_t* ob = (bf16_t*)(ws + WS_BR) + (size_t)tok0 * 1280 + 1024 + ch0;
            const float* bb = p.in[23] + (l * 4 + u.z * 2) * 128 + q0;
#pragma unroll
            EPI_LOOP_AI {
                EPI_SB; u32x4 duw[4]; float bias[4];
                EPI_LOOP_MB { duw[m] = *(const u32x4*)(dub + (size_t)(bj * 256 + m * 16) * NPROJ + ai * 64); bias[m] = bb[ai * 128 + m * 16]; }
                EPI_LOOP_MB { EPI_V; float du[8]; unpack8(duw[m], du);
#pragma unroll
                    for (int j = 0; j < 8; ++j) v[j] = du[j] * (v[j] + bias[m]);
                    *(u32x4*)(ob + (size_t)(bj * 256 + m * 16) * 1280 + ai * 64) = pack8(v); }
            }
        } break;
        case J_G2: {
            const bf16_t* gbase = (const bf16_t*)(ws + WS_GATES) + u.z * 1024;
            if (u.z == 3) {
#pragma unroll
                EPI_LOOP_AI {
                    EPI_SB; u32x4 g0[4];
                    EPI_LOOP_MB { EPI_RC; g0[m] = *(const u32x4*)(gbase + (size_t)row * 4096 + col); }
                    EPI_LOOP_MB { EPI_RC; EPI_V; float gt[8]; unpack8(g0[m], gt);
#pragma unroll
                        for (int j = 0; j < 8; ++j) v[j] *= gt[j];
                        *(u32x4*)((bf16_t*)(ws + WS_MERGED) + (size_t)row * 1024 + col) = pack8(v); }
                }
            }
        } break;
        case J_G3: case J_G5: {
            const int tile = u.z >> 1;
            unsigned* flag = (unsigned*)(ws + CTL_FLAG) + tile;
            const unsigned want = (unsigned)(2 * l + (job == J_G5 ? 2 : 1));
            const char* ppb = (const char*)(ws + WS_H) + (size_t)tile * 32 * 512 * 16;
            const unsigned pvo = TIDX * 16u;
            if (u.z & 1) {
#pragma unroll
                for (int ai = 0; ai < 2; ++ai)
#pragma unroll
                    for (int bj = 0; bj < 2; ++bj)
#pragma unroll
                        for (int m = 0; m < 4; ++m)
#pragma unroll
                            for (int n = 0; n < 2; ++n) { const unsigned o_ = pvo + (unsigned)((((ai * 2 + bj) * 4 + m) * 2 + n) * 8192); const f32x4 d_ = acc[ai][bj][m][n];
                                asm volatile("global_store_dwordx4 %0, %1, %2 sc0 sc1" :: "v"(o_), "v"(d_), "s"(ppb) : "memory"); }
                asm volatile("s_waitcnt vmcnt(0)" ::: "memory");
                __syncthreads();
                if (TIDX == 0) __hip_atomic_store(flag, want, __ATOMIC_RELAXED, __HIP_MEMORY_SCOPE_AGENT);
                break;
            }
            const int mi = u.r0 < TC ? 0 : 1 + ((u.r0 - TC) >> 11);
            const float* gmod = (const float*)(ws + CTL_MOD) + (size_t)(l * 3 + mi) * 6144 + (job == J_G3 ? 2048 : 5120);
            const bool from_in = (job == J_G3 && l == 0);
            const float* xin = from_in ? (u.r0 < TC ? p.in[0] : p.in[1] - (size_t)TC * 1024) : p.out;
            f32x4 gm[2][2];
#pragma unroll
            for (int bj = 0; bj < 2; ++bj) { gm[bj][0] = *(const f32x4*)(gmod + cbase + bj * 128); gm[bj][1] = *(const f32x4*)(gmod + cbase + bj * 128 + 4); }
#pragma unroll
            EPI_LOOP_AI {
                EPI_SB; f32x4 xv[4][2];
                EPI_LOOP_MB { EPI_RC; const float* xi = xin + (size_t)row * 1024 + col; xv[m][0] = *(const f32x4*)xi; xv[m][1] = *(const f32x4*)(xi + 4); }
                EPI_LOOP_MB { EPI_RC; float* xo = p.out + (size_t)row * 1024 + col;
                    *(f32x4*)xo = xv[m][0] + gm[bj][0] * acc[ai][bj][m][0]; *(f32x4*)(xo + 4) = xv[m][1] + gm[bj][1] * acc[ai][bj][m][1]; }
            }
        } break;
        case J_G4: {
#pragma unroll
            EPI_LOOP_AI { EPI_LOOP_MB { EPI_RC; EPI_V;
#pragma unroll
                for (int j = 0; j < 8; ++j) { const float r = fmaxf(v[j], 0.f); v[j] = r * r; }
                *(u32x4*)((bf16_t*)(ws + WS_GATES) + (size_t)row * 4096 + col) = pack8(v); } }
        } break;
        default: break;
        }
#undef EPI_LOOP_AI
#undef EPI_SB
#undef EPI_LOOP_MB
#undef EPI_RC
#undef EPI_V
    }
    DI void pre(f32x4 (&acc)[2][2][4][2], const pg8::Unit& u) const {
        if (!(job == J_G5 && !(u.z & 1))) return;
        const int tile = u.z >> 1;
        unsigned* flag = (unsigned*)(p.ws + CTL_FLAG) + tile;
        const unsigned want = (unsigned)(2 * l + (job == J_G5 ? 2 : 1));
        const char* ppb = (const char*)(p.ws + WS_H) + (size_t)tile * 32 * 512 * 16;
        const unsigned pvo = TIDX * 16u;
        if (TIDX == 0) { unsigned sp_ = 0; while (__hip_atomic_load(flag, __ATOMIC_RELAXED, __HIP_MEMORY_SCOPE_AGENT) < want) { __builtin_amdgcn_s_sleep(1); if (++sp_ > (1u << 22)) break; } }
        __syncthreads();
#pragma unroll
        for (int ai = 0; ai < 2; ++ai)
#pragma unroll
            for (int bj = 0; bj < 2; ++bj) {
                const unsigned o_ = pvo + (unsigned)(((ai * 2 + bj) * 8) * 8192);
                f32x4 q0, q1, q2, q3, q4, q5, q6, q7;
                asm volatile("global_load_dwordx4 %0, %8, %16 sc0 sc1\n\tglobal_load_dwordx4 %1, %9, %16 sc0 sc1\n\tglobal_load_dwordx4 %2, %10, %16 sc0 sc1\n\tglobal_load_dwordx4 %3, %11, %16 sc0 sc1\n\t"
                             "global_load_dwordx4 %4, %12, %16 sc0 sc1\n\tglobal_load_dwordx4 %5, %13, %16 sc0 sc1\n\tglobal_load_dwordx4 %6, %14, %16 sc0 sc1\n\tglobal_load_dwordx4 %7, %15, %16 sc0 sc1\n\ts_waitcnt vmcnt(0)"
                             : "=&v"(q0), "=&v"(q1), "=&v"(q2), "=&v"(q3), "=&v"(q4), "=&v"(q5), "=&v"(q6), "=&v"(q7)
                             : "v"(o_), "v"(o_ + 8192u), "v"(o_ + 16384u), "v"(o_ + 24576u), "v"(o_ + 32768u), "v"(o_ + 40960u), "v"(o_ + 49152u), "v"(o_ + 57344u), "s"(ppb) : "memory");
                acc[ai][bj][0][0] += q0; acc[ai][bj][0][1] += q1; acc[ai][bj][1][0] += q2; acc[ai][bj][1][1] += q3;
                acc[ai][bj][2][0] += q4; acc[ai][bj][2][1] += q5; acc[ai][bj][3][0] += q6; acc[ai][bj][3][1] += q7;
            }
    }
    DI void scale(f32x4 (&acc)[2][2][4][2], const pg8::Unit& u, int wr, int wc, int fr, int fq) const {
        if (!(job == J_G2 && u.z < 3)) return;
        const bf16_t* gbase = (const bf16_t*)(p.ws + WS_GATES) + u.z * 1024 + (size_t)(u.r0 + wr * 64 + fr) * 4096 + u.c0 + wc * 32 + 8 * fq;
#pragma unroll
        for (int ai = 0; ai < 2; ++ai)
#pragma unroll
            for (int m = 0; m < 4; m += 2) {
                u32x4 g0[2][2], g1[2][2];
#pragma unroll
                for (int mm = 0; mm < 2; ++mm)
#pragma unroll
                    for (int bj = 0; bj < 2; ++bj) { const bf16_t* gp = gbase + (size_t)(ai * 128 + (m + mm) * 16) * 4096 + bj * 128; g0[mm][bj] = *(const u32x4*)gp; g1[mm][bj] = *(const u32x4*)(gp + 1024); }
#pragma unroll
                for (int mm = 0; mm < 2; ++mm)
#pragma unroll
                    for (int bj = 0; bj < 2; ++bj) {
                        float gt[8], gn[8]; unpack8(g0[mm][bj], gt); unpack8(g1[mm][bj], gn);
#pragma unroll
                        for (int j = 0; j < 8; ++j) gt[j] *= __builtin_amdgcn_rcpf(fmaxf(gn[j], 1e-30f));
#pragma unroll
                        for (int j = 0; j < 4; ++j) { acc[ai][bj][m + mm][0][j] *= gt[j]; acc[ai][bj][m + mm][1][j] *= gt[4 + j]; }
                    }
                asm volatile("" ::: "memory");
            }
    }
};

DI void transpose_item(const float* W, int ld, int ncols, bf16_t* WT, int ldw, int koff, int row_off, LAS float* scr, int item, int lane) {
    const int nblk = ncols / 32, kb = item / nblk, nb = item % nblk, k0 = 64 * kb, n0 = 32 * nb;
    float tv[32];
#pragma unroll
    for (int i = 0; i < 32; ++i) { const int kk = 2 * i + (lane >> 5); tv[i] = W[(size_t)(k0 + kk) * ld + n0 + (lane & 31)]; }
#pragma unroll
    for (int i = 0; i < 32; ++i) { const int kk = 2 * i + (lane >> 5); scr[kk * 33 + (lane & 31)] = tv[i]; }
    asm volatile("s_waitcnt lgkmcnt(0)" ::: "memory");
    const int c = lane & 7;
#pragma unroll
    for (int j = 0; j < 4; ++j) { const int n = (lane >> 3) + 8 * j; const LAS float* s = scr + (8 * c) * 33 + n;
        u32x4 o; o.x = cvtpk(s[0 * 33], s[1 * 33]); o.y = cvtpk(s[2 * 33], s[3 * 33]); o.z = cvtpk(s[4 * 33], s[5 * 33]); o.w = cvtpk(s[6 * 33], s[7 * 33]);
        *(u32x4*)(WT + (size_t)(row_off + n0 + n) * ldw + koff + k0 + 8 * c) = o; }
    asm volatile("s_waitcnt lgkmcnt(0)" ::: "memory");
}

DI void prologue(const Params& p, LAS unsigned char* lds, const int lbeg, const int nl, const int vb, const int nvb, const bool common) {
    const int tid_ = opaque_v(TIDX), lane = tid_ & 63, wave = __builtin_amdgcn_readfirstlane(tid_ >> 6), gw = vb * NWAVES + wave, NGW = nvb * NWAVES;
    unsigned char* ws = p.ws;
    LAS float* scr = (LAS float*)(lds + wave * 8448);
    LAS float* tw = (LAS float*)(lds + 8 * 8448);
    if (TIDX < 128) { const int m = TIDX & 63; const float a = (float)m * (2.0f / 64.0f); tw[TIDX] = TIDX < 64 ? cospif(a) : sinpif(a); }
    __syncthreads();
    for (int it = gw; it < nl * 7936; it += NGW) {
        const int l = lbeg + it / 7936; int r = it % 7936;
        unsigned char* wl = ws + WS_W + (size_t)l * W_LAYER;
        if (r < 896) { transpose_item(p.in[12] + (size_t)l * 1024 * 2048 + 256, 2048, 1792, (bf16_t*)(wl + W_CAT), 1024, 0, 0, scr, r, lane); continue; } r -= 896;
        if (r < 2048) { transpose_item(p.in[24] + (size_t)l * 1024 * 4096, 4096, 4096, (bf16_t*)(wl + W_CAT), 1024, 0, 1792, scr, r, lane); continue; } r -= 2048;
        if (r < 384) { const int n = r / 128 + 1; transpose_item(p.in[25] + (size_t)(l * 4 + n) * 256 * 1024, 1024, 1024, (bf16_t*)(wl + W_BALL), 1280, 256 + 256 * n, 0, scr, r % 128, lane); continue; } r -= 384;
        if (r < 512) { transpose_item(p.in[26] + (size_t)l * 1024 * 1024, 1024, 1024, (bf16_t*)(wl + W_OUT), 1024, 0, 0, scr, r, lane); continue; } r -= 512;
        if (r < 2048) { transpose_item(p.in[27] + (size_t)l * 1024 * 4096, 4096, 4096, (bf16_t*)(wl + W_1), 1024, 0, 0, scr, r, lane); continue; } r -= 2048;
        transpose_item(p.in[28] + (size_t)l * 4096 * 1024, 1024, 1024, (bf16_t*)(wl + W_2), 4096, 0, 0, scr, r, lane);
    }
    {
        LAS f32x4* red = (LAS f32x4*)(lds + 69632);
        for (int bi = vb; bi < nl * 24; bi += nvb) {
            const int l = lbeg + bi / 24, cc = bi % 24, n0 = cc * 256 + lane * 4, k0 = wave * 128;
            f32x4 a0 = {0.f, 0.f, 0.f, 0.f}, a1 = a0, a2 = a0;
            const float* wp = p.in[8] + ((size_t)l * 1024 + k0) * 6144 + n0;
#pragma unroll 32
            for (int kk = 0; kk < 128; ++kk) {
                const f32x4 w = *(const f32x4*)(wp + (size_t)kk * 6144);
                const float c0 = p.in[7][k0 + kk], c1 = p.in[2][k0 + kk], c2 = p.in[2][1024 + k0 + kk];
                const float s0 = c0 * sigmoidf_(c0), s1 = c1 * sigmoidf_(c1), s2 = c2 * sigmoidf_(c2);
                a0 += w * s0; a1 += w * s1; a2 += w * s2;
            }
            red[(wave * 3 + 0) * 64 + lane] = a0; red[(wave * 3 + 1) * 64 + lane] = a1; red[(wave * 3 + 2) * 64 + lane] = a2;
            __syncthreads();
            if (TIDX < 192) {
                const int m = TIDX >> 6, ln = TIDX & 63;
                f32x4 sacc = *(const f32x4*)(p.in[9] + (size_t)l * 6144 + cc * 256 + ln * 4);
#pragma unroll
                for (int w = 0; w < 8; ++w) sacc += red[(w * 3 + m) * 64 + ln];
                *(f32x4*)((float*)(ws + CTL_MOD) + (size_t)(l * 3 + m) * 6144 + cc * 256 + ln * 4) = sacc;
            }
            __syncthreads();
        }
    }
    for (int it = (gw >= 1024 ? gw - 1024 : gw + NGW - 1024); it < nl * 128; it += NGW) {
        const int l = lbeg + it / 128, r = it % 128, g = r / 32, cs = (r / 16) & 1, d = (r % 16) * 64 + lane;
        float x[64];
        const float* src = p.in[12] + ((size_t)l * 1024 + d) * 2048 + g * 64;
#pragma unroll
        for (int j = 0; j < 16; ++j) { const f32x4 w = *(const f32x4*)(src + 4 * j); x[4 * j] = w[0]; x[4 * j + 1] = w[1]; x[4 * j + 2] = w[2]; x[4 * j + 3] = w[3]; }
        bf16_t* dst = (bf16_t*)(ws + WS_W + (size_t)l * W_LAYER + W_A) + (size_t)(g * 128 + cs * 64) * 1024 + d;
        for (int cp = 0; cp < 64; ++cp) {
            float a = 0.f;
#pragma unroll
            for (int c = 0; c < 64; ++c) a += x[c] * tw[cs * 64 + ((c * cp) & 63)];
            dst[(size_t)cp * 1024] = (bf16_t)(cvtpk(a * 0.125f, 0.f) & 0xffffu);
        }
    }
    for (int it = gw; it < nl * 512; it += NGW) {
        const int l = lbeg + it / 512, r = it % 512, r0 = (r / 16) * 8, d = (r % 16) * 64 + lane;
        float a[8];
#pragma unroll
        for (int j = 0; j < 8; ++j) a[j] = 0.f;
        const float* wb = p.in[25] + (size_t)(l * 4) * 256 * 1024 + d;
        const float* wf = p.in[13] + ((size_t)l * 256 + r0) * 256;
#pragma unroll 2
        for (int jb = 0; jb < 256; jb += 8) {
            float b[8];
#pragma unroll
            for (int jj = 0; jj < 8; ++jj) b[jj] = wb[(size_t)(jb + jj) * 1024];
#pragma unroll
            for (int rr = 0; rr < 8; ++rr)
#pragma unroll
                for (int jj = 0; jj < 8; ++jj) a[rr] += wf[rr * 256 + jb + jj] * b[jj];
        }
        bf16_t* dst = (bf16_t*)(ws + WS_W + (size_t)l * W_LAYER + W_BALL) + (size_t)d * 1280 + r0;
        const u32x4 o = pack8(a);
        *(u32x4*)dst = o; *(u32x4*)(dst + 256) = o;
    }
    for (int it = gw - (NGW >= 2048 ? 1536 : 0); it >= 0 && it < nl * 256; it += NGW - (NGW >= 2048 ? 1536 : 0)) {
        const int idx = it * 64 + lane, k8 = idx & 31, m = (idx >> 5) & 255, pair = (idx >> 13) & 1, l = lbeg + (idx >> 14);
        const int gsel = m >> 7, q = m & 127, ksel = k8 >> 4, p0 = (k8 & 15) * 8;
        u32x4 o = {0u, 0u, 0u, 0u};
        if (gsel == ksel) { const float* s = p.in[22] + ((size_t)(l * 4 + pair * 2 + gsel) * 128 + q) * 128 + p0; float f[8];
#pragma unroll
            for (int j = 0; j < 8; ++j) f[j] = s[j];
            o = pack8(f); }
        *(u32x4*)((bf16_t*)(ws + WS_W + (size_t)l * W_LAYER + W_SP) + ((size_t)pair * 256 + m) * 256 + k8 * 8) = o;
    }
    if (common)
    for (int it = gw; it < 256 + 16384; it += NGW) {
        const bool ctx = it < 256;
        const int idx = (ctx ? it : it - 256) * 64 + lane;
        const int L = ctx ? 256 : 2048, c8n = ctx ? 64 : 512;
        const int j = idx / c8n, kk0 = (idx % c8n) * 8;
        const float sc = ctx ? 0.0625f : 0.022097086912079608f;
        float f[8];
#pragma unroll
        for (int e = 0; e < 8; ++e) { const int kk = kk0 + e, part = kk >= L, k = kk & (L - 1), mm = (j * k) & (L - 1);
            const float a = (float)(2 * mm) / (float)L; f[e] = (part ? -sinpif(a) : cospif(a)) * sc; }
        *(u32x4*)((bf16_t*)(ws + (ctx ? WS_FCTX : WS_FLAT)) + (size_t)j * (2 * L) + kk0) = pack8(f);
    }
    if (common && blockIdx.x == 0 && TIDX < 4) {
        const int l = TIDX; float s1 = 0.f, s2 = 0.f;
        for (int i = 0; i < 32; ++i) { s1 += p.in[16][l * 32 + i] * p.in[17][l * 32 + i]; s2 += p.in[18][l * 32 + i] * p.in[19][l * 32 + i]; }
        const float lam_init = 0.8f - 0.6f * expf(-0.3f * (float)l);
        ((float*)(ws + CTL_LAM))[l] = expf(s1) - expf(s2) + lam_init;
    }
}

DI void norm_phase(const Params& p, int l, int which) {
    const int tid_ = opaque_v(TIDX), lane = tid_ & 63, wave = __builtin_amdgcn_readfirstlane(tid_ >> 6), gw = blockIdx.x * NWAVES + wave, NGW = gridDim.x * NWAVES;
    unsigned char* ws = p.ws;
    constexpr int KR = 3;
    const float* gg = (which == 0 ? p.in[10] + l * 1024 : which == 1 ? p.in[11] + l * 1024 : p.in[29]);
    for (int row0 = gw; row0 < T; row0 += KR * NGW) {
        f32x4 v[KR][4]; float ss[KR];
#pragma unroll
        for (int k = 0; k < KR; ++k) { const int row = row0 + k * NGW < T ? row0 + k * NGW : row0;
            const float* xr = (l == 0 && which == 0) ? (row < TC ? p.in[0] + (size_t)row * 1024 : p.in[1] + (size_t)(row - TC) * 1024) : p.out + (size_t)row * 1024;
#pragma unroll
            for (int j = 0; j < 4; ++j) v[k][j] = *(const f32x4*)(xr + 4 * lane + 256 * j); }
#pragma unroll
        for (int k = 0; k < KR; ++k) { float s_ = 0.f;
#pragma unroll
            for (int j = 0; j < 4; ++j) s_ += (v[k][j].x * v[k][j].x + v[k][j].y * v[k][j].y) + (v[k][j].z * v[k][j].z + v[k][j].w * v[k][j].w);
            ss[k] = s_; }
#pragma unroll
        for (int o = 1; o < 64; o <<= 1) {
#pragma unroll
            for (int k = 0; k < KR; ++k) ss[k] += __shfl_xor(ss[k], o); }
#pragma unroll
        for (int k = 0; k < KR; ++k) {
            const int row = row0 + k * NGW;
            if (row >= T) break;
            const float rms = rsqrtf(ss[k] * (1.f / 1024.f) + EPS);
            if (which < 2) {
                const int mi = row < TC ? 0 : 1 + ((row - TC) >> 11);
                const float* md = (const float*)(ws + CTL_MOD) + (size_t)(l * 3 + mi) * 6144;
                const float* shp = md + (which == 0 ? 0 : 3072); const float* scp = md + (which == 0 ? 1024 : 4096);
                bf16_t* o = (bf16_t*)(ws + WS_H) + (size_t)row * 1024;
#pragma unroll
                for (int j = 0; j < 4; ++j) { const int c = 4 * lane + 256 * j; const f32x4 g = *(const f32x4*)(gg + c), sc = *(const f32x4*)(scp + c), sh = *(const f32x4*)(shp + c);
                    const f32x4 y = v[k][j] * rms * g * (sc + 1.f) + sh;
                    u32x2 w; w.x = cvtpk(y.x, y.y); w.y = cvtpk(y.z, y.w); *(u32x2*)(o + c) = w; }
            } else {
                float* o = p.out + (size_t)row * 1024;
#pragma unroll
                for (int j = 0; j < 4; ++j) { const int c = 4 * lane + 256 * j; const f32x4 g = *(const f32x4*)(gg + c); *(f32x4*)(o + c) = v[k][j] * rms * g; }
            }
        }
    }
}

template <int N> DI void load_bf(const bf16_t* src, float* v) {
#pragma unroll
    for (int j = 0; j < N / 8; ++j) unpack8(*(const u32x4*)(src + 8 * j), v + 8 * j);
}
template <int N> DI void load_f32(const float* src, float* v) {
#pragma unroll
    for (int j = 0; j < N / 4; ++j) { const f32x4 w = *(const f32x4*)(src + 4 * j); v[4 * j] = w[0]; v[4 * j + 1] = w[1]; v[4 * j + 2] = w[2]; v[4 * j + 3] = w[3]; }
}
template <int N> DI void store_bf(bf16_t* dst, const float* v) {
#pragma unroll
    for (int j = 0; j < N / 8; ++j) *(u32x4*)(dst + 8 * j) = pack8(v + 8 * j);
}
template <int N> DI void store_f32(float* dst, const float* v) {
#pragma unroll
    for (int j = 0; j < N / 4; ++j) *(f32x4*)(dst + 4 * j) = (f32x4){v[4 * j], v[4 * j + 1], v[4 * j + 2], v[4 * j + 3]};
}
template <int N> DI void store_tr(bf16_t* dst, size_t stride, const float* v) {
#pragma unroll
    for (int d = 0; d < N; d += 2) { const unsigned w = cvtpk(v[d], v[d + 1]); dst[(size_t)d * stride] = (bf16_t)(w & 0xffffu); dst[(size_t)(d + 1) * stride] = (bf16_t)(w >> 16); }
}
template <int N> DI void store_kfrag(bf16_t* base, int key, const float* v) {
    const int tile = key >> 5, r = key & 31;
#pragma unroll
    for (int s = 0; s < N / 16; ++s)
#pragma unroll
        for (int h = 0; h < 2; ++h) *(u32x4*)(base + ((size_t)((tile * (N / 16) + s) * 64 + h * 32 + r)) * 8) = pack8(v + 16 * s + 8 * h);
}
DI void store_vfrag(bf16_t* base, int key, const float* v) {
    const int tile = key >> 5, sp = (key >> 4) & 1, kk = key & 15, h = (kk >> 2) & 1, j = ((kk >> 3) << 2) | (kk & 3);
    bf16_t* b0 = base + ((size_t)(tile * 4 + sp) * 64 + h * 32) * 8 + j;
#pragma unroll
    for (int d = 0; d < 64; d += 2) { const unsigned w = cvtpk(v[d], v[d + 1]);
        b0[(size_t)((d >> 5) * 2 * 64 + (d & 31)) * 8] = (bf16_t)(w & 0xffffu); b0[(size_t)((d >> 5) * 2 * 64 + ((d + 1) & 31)) * 8] = (bf16_t)(w >> 16); }
}
template <int N> DI void rms_scale(float* v, const float* g) {
    float ss = 0.f;
#pragma unroll
    for (int d = 0; d < N; ++d) ss += v[d] * v[d];
    const float r = rsqrtf(ss * (1.f / N) + EPS);
#pragma unroll
    for (int d = 0; d < N; ++d) v[d] = v[d] * r * g[d];
}
template <int N> DI void rope(float* v, int pos) {
#pragma unroll
    for (int i0 = 0; i0 < N / 2; i0 += 8) {
        const int pk = opaque_v(pos);
        const float frow = (float)(pk >> 6), fcol = (float)(pk & 63);
#pragma unroll
        for (int i = i0; i < i0 + 8; ++i) {
            const int q = i % (N / 4);
            const float inv = exp2f(-(float)q * (13.287712379549449f / (float)(N / 4)));
            const float ang = (i < N / 4 ? frow : fcol) * inv;
            const float c = __cosf(ang), s = __sinf(ang);
            const float x1 = v[i], x2 = v[i + N / 2];
            v[i] = x1 * c - x2 * s; v[i + N / 2] = x1 * s + x2 * c;
        }
    }
}

DI void pp_phase(const Params& p, int l) {
    const int tid_ = opaque_v(TIDX), lane = tid_ & 63, wave = __builtin_amdgcn_readfirstlane(tid_ >> 6), gw = blockIdx.x * NWAVES + wave, NGW = gridDim.x * NWAVES;
    unsigned char* ws = p.ws;
    const bf16_t* proj = (const bf16_t*)(ws + WS_PROJ);
    unsigned char* att = ws + WS_ATT;
    constexpr int NT_ITEMS = 192 * 29, NC_ITEMS = 16 * 16;
    for (int it = gw; it < NT_ITEMS + NC_ITEMS; it += NGW) {
        if (it < NT_ITEMS) {
            const int tile = it / 29, task = it % 29, t = tile * 64 + lane;
            const bool ctx = t < TC;
            const int b = ctx ? (t >> 8) : ((t - TC) >> 11), s = ctx ? (t & 255) : ((t - TC) & 2047);
            const bf16_t* prow = proj + (size_t)t * NPROJ;
            if (task < 4) {
                float v[64]; load_bf<64>(prow + task * 64, v);
                rms_scale<64>(v, p.in[14] + l * 64);
                if (!ctx) rope<64>(v, s);
                store_bf<64>((bf16_t*)(att + A_QB) + (size_t)t * 256 + task * 64, v);
            } else if (task < 6) {
                const int hk = task - 4;
                float v[64]; load_bf<64>(prow + 256 + hk * 64, v);
                rms_scale<64>(v, p.in[15] + l * 64);
                if (ctx) { store_f32<64>(p.out + O_GK + ((size_t)((b * 4 + l) * 256 + s) * 2 + hk) * 64, v);
                           store_kfrag<64>((bf16_t*)(att + A_KBC) + (size_t)(b * 2 + hk) * 256 * 64, s, v); }
                else { rope<64>(v, s); store_kfrag<64>((bf16_t*)(att + A_KBL) + (size_t)(b * 2 + hk) * 2560 * 64, 512 + s, v); }
            } else if (task < 8) {
                const int hk = task - 6;
                float v[64]; load_bf<64>(prow + 384 + hk * 64, v);
                if (ctx) { store_f32<64>(p.out + O_GV + ((size_t)((b * 4 + l) * 256 + s) * 2 + hk) * 64, v);
                           store_vfrag((bf16_t*)(att + A_VBC) + (size_t)(b * 2 + hk) * 64 * 256, s, v); }
                else store_vfrag((bf16_t*)(att + A_VBL) + (size_t)(b * 2 + hk) * 64 * 2560, 512 + s, v);
            } else if (task < 16) {
                const int hm = task - 8;
                if (!ctx) {
                    float v[32]; load_bf<32>(prow + 512 + hm * 32, v);
                    rope<32>(v, s);
                    store_bf<32>((bf16_t*)(att + A_QC) + (size_t)t * 256 + hm * 32, v);
                }
            } else if (task < 24) {
                const int hm = task - 16;
                float v[32]; load_bf<32>(prow + 768 + hm * 32, v);
                if (ctx) { store_f32<32>(p.out + O_DK + ((size_t)((b * 4 + l) * 256 + s) * 8 + hm) * 32, v);
                           store_kfrag<32>((bf16_t*)(att + A_KCC) + (size_t)(b * 8 + hm) * 256 * 32, s, v); }
                else { rope<32>(v, s); store_kfrag<32>((bf16_t*)(att + A_KCL) + (size_t)(b * 8 + hm) * 2560 * 32, 512 + s, v); }
            } else if (task < 28) {
                const int h = task - 24;
                float v[64]; load_bf<64>(prow + 1024 + h * 64, v);
                if (ctx) { store_f32<64>(p.out + O_DV + ((size_t)((b * 4 + l) * 256 + s) * 4 + h) * 64, v);
                           store_vfrag((bf16_t*)(att + A_VCC) + (size_t)(b * 4 + h) * 64 * 256, s, v); }
                else store_vfrag((bf16_t*)(att + A_VCL) + (size_t)(b * 4 + h) * 64 * 2560, 512 + s, v);
            } else {
                float ss = 0.f;
#pragma unroll 1
                for (int jb = 0; jb < 32; jb += 8) {
                    u32x4 rw[8];
#pragma unroll
                    for (int j = 0; j < 8; ++j) rw[j] = *(const u32x4*)(prow + 1536 + 8 * (jb + j));
#pragma unroll
                    for (int j = 0; j < 8; ++j) { float v[8]; unpack8(rw[j], v);
#pragma unroll
                        for (int e = 0; e < 8; ++e) ss += v[e] * v[e]; }
                }
                const float r = rsqrtf(ss * (1.f / 256.f) + EPS);
                const int chunk = t >> 7, pp = t & 127;
                const float* sg = p.in[21] + l * 256;
                bf16_t* dvt = (bf16_t*)(ws + WS_DVT);
#pragma unroll 1
                for (int jb = 0; jb < 32; jb += 8) {
                    u32x4 rw[8];
#pragma unroll
                    for (int j = 0; j < 8; ++j) rw[j] = *(const u32x4*)(prow + 1536 + 8 * (jb + j));
                    const int g = jb >> 3;
                    bf16_t* d0 = dvt + ((size_t)((g >> 1) * 6144 + chunk * 64) * 256 + (g & 1) * 128 + pp);
#pragma unroll
                    for (int j = 0; j < 8; ++j) { float v[8]; unpack8(rw[j], v);
                        const f32x4 s0 = *(const f32x4*)(sg + 8 * (jb + j)), s1 = *(const f32x4*)(sg + 8 * (jb + j) + 4);
                        const float sv[8] = {s0.x, s0.y, s0.z, s0.w, s1.x, s1.y, s1.z, s1.w};
#pragma unroll
                        for (int e = 0; e < 8; e += 2) { const int c = 8 * j + e;
                            const unsigned w = cvtpk(v[e] * r * sv[e], v[e + 1] * r * sv[e + 1]);
                            d0[(size_t)c * 256] = (bf16_t)(w & 0xffffu); d0[(size_t)(c + 1) * 256] = (bf16_t)(w >> 16); } }
                }
            }
        } else {
            const int ci = it - NT_ITEMS, tile = ci / 16, task = ci % 16, ct = tile * 64 + lane, b = ct >> 9, pos = ct & 511;
            const size_t crow = (size_t)(b * 4 + l) * 512 + pos;
            if (task < 2) { float v[64]; load_f32<64>(p.in[3] + (crow * 2 + task) * 64, v); store_kfrag<64>((bf16_t*)(att + A_KBL) + (size_t)(b * 2 + task) * 2560 * 64, pos, v); }
            else if (task < 4) { const int hk = task - 2; float v[64]; load_f32<64>(p.in[4] + (crow * 2 + hk) * 64, v); store_vfrag((bf16_t*)(att + A_VBL) + (size_t)(b * 2 + hk) * 64 * 2560, pos, v); }
            else if (task < 12) { const int hm = task - 4; float v[32]; load_f32<32>(p.in[5] + (crow * 8 + hm) * 32, v); store_kfrag<32>((bf16_t*)(att + A_KCL) + (size_t)(b * 8 + hm) * 2560 * 32, pos, v); }
            else { const int h = task - 12; float v[64]; load_f32<64>(p.in[6] + (crow * 4 + h) * 64, v); store_vfrag((bf16_t*)(att + A_VCL) + (size_t)(b * 4 + h) * 64 * 2560, pos, v); }
        }
    }
}

#define MFMA32(a, b, c) __builtin_amdgcn_mfma_f32_32x32x16_bf16((a), (b), (c), 0, 0, 0)
template <int DQK, int NMAP>
DI void attn_core(const bf16_t* Q, int ldq, const bf16_t* K, size_t kmapstride, const bf16_t* VT, int kb, int ke, float cs, f32x16 (&o)[NMAP][2], float (&mrun)[NMAP], float (&lrun)[NMAP], int lane) {
    constexpr int NS = DQK / 16;
    const int r = lane & 31, h = lane >> 5;
    bf16x8 qf[NMAP][NS];
#pragma unroll
    for (int mp = 0; mp < NMAP; ++mp)
#pragma unroll
        for (int s = 0; s < NS; ++s) qf[mp][s] = *(const bf16x8*)(Q + (size_t)r * ldq + mp * 32 + 16 * s + 8 * h);
#pragma unroll
    for (int mp = 0; mp < NMAP; ++mp) { mrun[mp] = -1e30f; lrun[mp] = 0.f;
#pragma unroll
        for (int i = 0; i < 16; ++i) { o[mp][0][i] = 0.f; o[mp][1][i] = 0.f; } }
    const unsigned lo16 = (unsigned)lane * 16u;
    bf16x8 Ka[NMAP][NS], Kb[NMAP][NS], Va[2][2], Vb[2][2];
    f32x16 Sx, Sy;
    bf16x8 P0a, P0b, P1a, P1b;
#define AT_LOADK(Kx, tile) do { _Pragma("unroll") for (int mp_ = 0; mp_ < NMAP; ++mp_) _Pragma("unroll") for (int s_ = 0; s_ < NS; ++s_) \
        Kx[mp_][s_] = *(const bf16x8*)((const char*)K + ((size_t)mp_ * kmapstride + (size_t)((tile) * NS + s_) * 512) * 2 + lo16); } while (0)
#define AT_LOADV(Vx, tile) do { _Pragma("unroll") for (int mt_ = 0; mt_ < 2; ++mt_) _Pragma("unroll") for (int sp_ = 0; sp_ < 2; ++sp_) \
        Vx[mt_][sp_] = *(const bf16x8*)((const char*)VT + (size_t)(((tile) * 2 + mt_) * 2 + sp_) * 1024 + lo16); } while (0)
#define AT_QK(Sd, Kx, mp) do { _Pragma("unroll") for (int i_ = 0; i_ < 16; ++i_) Sd[i_] = 0.f; _Pragma("unroll") for (int s_ = 0; s_ < NS; ++s_) Sd = MFMA32(Kx[mp][s_], qf[mp][s_], Sd); } while (0)
#define AT_PV(Pa_, Pb_, Vx, mp) do { _Pragma("unroll") for (int mt_ = 0; mt_ < 2; ++mt_) { o[mp][mt_] = MFMA32(Vx[mt_][0], Pa_, o[mp][mt_]); o[mp][mt_] = MFMA32(Vx[mt_][1], Pb_, o[mp][mt_]); } } while (0)
#define AT_SOFTMAX(S, mp, Pa_, Pb_) do { \
        float mx = fmaxf(fmaxf(S[0], S[1]), fmaxf(S[2], S[3])); \
        _Pragma("unroll") for (int i = 4; i < 16; i += 4) mx = fmaxf(mx, fmaxf(fmaxf(S[i], S[i + 1]), fmaxf(S[i + 2], S[i + 3]))); \
        { const auto sw_ = __builtin_amdgcn_permlane32_swap(__builtin_bit_cast(unsigned, mx), __builtin_bit_cast(unsigned, mx), false, false); \
          mx = fmaxf(__builtin_bit_cast(float, sw_[0]), __builtin_bit_cast(float, sw_[1])); } \
        if (__builtin_amdgcn_ballot_w64(mx > mrun[mp]) != 0ull) { \
            const float mn = fmaxf(mrun[mp], mx); \
            const float alpha = __builtin_amdgcn_exp2f((mrun[mp] - mn) * cs); \
            mrun[mp] = mn; lrun[mp] *= alpha; \
            o[mp][0] *= alpha; o[mp][1] *= alpha; \
        } \
        const float nb = mrun[mp] * cs; \
        float ps = 0.f; \
        { float pv[8]; _Pragma("unroll") for (int i = 0; i < 8; ++i) { pv[i] = __builtin_amdgcn_exp2f(S[i] * cs - nb); ps += pv[i]; } Pa_ = __builtin_bit_cast(bf16x8, pack8(pv)); } \
        { float pv[8]; _Pragma("unroll") for (int i = 0; i < 8; ++i) { pv[i] = __builtin_amdgcn_exp2f(S[8 + i] * cs - nb); ps += pv[i]; } Pb_ = __builtin_bit_cast(bf16x8, pack8(pv)); } \
        lrun[mp] += ps; \
    } while (0)
    const int t0 = kb >> 5, t1 = ke >> 5, tl = t1 - 1;
#define AT_CL(t) ((t) < tl ? (t) : tl)
    AT_LOADK(Ka, t0); AT_LOADV(Va, t0); AT_LOADK(Kb, t0 + 1); AT_LOADV(Vb, t0);
    AT_QK(Sx, Ka, 0);
    { const bf16x8 z = {0, 0, 0, 0, 0, 0, 0, 0}; P0a = z; P0b = z; P1a = z; P1b = z; }
    if constexpr (NMAP == 1) {
        AT_LOADK(Ka, AT_CL(t0 + 2));
        for (int t = t0; t < t1; t += 2) {
            AT_QK(Sy, Kb, 0); AT_LOADK(Kb, AT_CL(t + 3));
            AT_PV(P1a, P1b, Vb, 0); AT_LOADV(Vb, t + 1);
            AT_SOFTMAX(Sx, 0, P0a, P0b);
            AT_QK(Sx, Ka, 0); AT_LOADK(Ka, AT_CL(t + 4));
            AT_PV(P0a, P0b, Va, 0); AT_LOADV(Va, AT_CL(t + 2));
            AT_SOFTMAX(Sy, 0, P1a, P1b);
        }
        AT_PV(P1a, P1b, Vb, 0);
    } else {
        for (int t = t0; t < t1; t += 2) {
            AT_QK(Sy, Ka, 1); AT_LOADK(Ka, AT_CL(t + 2));
            AT_PV(P0a, P0b, Va, 0); AT_PV(P1a, P1b, Va, 1); AT_LOADV(Va, t);
            AT_SOFTMAX(Sx, 0, P0a, P0b);
            AT_QK(Sx, Kb, 0);
            AT_SOFTMAX(Sy, 1, P1a, P1b);
            AT_QK(Sy, Kb, 1); AT_LOADK(Kb, AT_CL(t + 3));
            AT_PV(P0a, P0b, Va, 0); AT_PV(P1a, P1b, Va, 1); AT_LOADV(Va, t + 1);
            AT_SOFTMAX(Sx, 0, P0a, P0b);
            AT_QK(Sx, Ka, 0);
            AT_SOFTMAX(Sy, 1, P1a, P1b);
        }
        AT_PV(P0a, P0b, Va, 0); AT_PV(P1a, P1b, Va, 1);
    }
#undef AT_LOADK
#undef AT_LOADV
#undef AT_QK
#undef AT_PV
#undef AT_SOFTMAX
#undef AT_CL
}

template <int DQK, int NMAP>
DI void attn_core_staged(const bf16_t* Q, const bf16_t* K, size_t kmapstride, const bf16_t* VT, int half, int ntile, float cs, f32x16 (&o)[NMAP][2], float (&mrun)[NMAP], float (&lrun)[NMAP],
                         int lane, int wave, LAS unsigned char* ring) {
    constexpr int NS = DQK / 16;
    const int r = lane & 31, h = lane >> 5;
    bf16x8 qf[NMAP][NS];
#pragma unroll
    for (int mp = 0; mp < NMAP; ++mp)
#pragma unroll
        for (int s = 0; s < NS; ++s) qf[mp][s] = *(const bf16x8*)(Q + (size_t)r * 256 + mp * 32 + 16 * s + 8 * h);
#pragma unroll
    for (int mp = 0; mp < NMAP; ++mp) { mrun[mp] = -1e30f; lrun[mp] = 0.f;
#pragma unroll
        for (int i = 0; i < 16; ++i) { o[mp][0][i] = 0.f; o[mp][1][i] = 0.f; } }
    const char* src[2]; size_t tstride[2];
#pragma unroll
    for (int j = 0; j < 2; ++j) { const int pc = 2 * wave + j, hh = pc >> 3, q = pc & 7;
        if (q < 4) { const int mp = NMAP == 1 ? 0 : (q >> 1), sx = NMAP == 1 ? q : (q & 1);
            src[j] = (const char*)K + ((size_t)mp * kmapstride + (size_t)((hh * ntile) * NS + sx) * 512) * 2 + lane * 16; tstride[j] = (size_t)NS * 1024; }
        else { src[j] = (const char*)VT + (size_t)(((hh * ntile) * 2 + ((q - 4) >> 1)) * 2 + ((q - 4) & 1)) * 1024 + lane * 16; tstride[j] = 4096; } }
#define AS_ISSUE(t) do { _Pragma("unroll") for (int j_ = 0; j_ < 2; ++j_) \
        __builtin_amdgcn_global_load_lds((const unsigned*)(src[j_] + (size_t)(t) * tstride[j_]), (LAS unsigned*)(ring + ((t) & 3) * 16384 + (2 * wave + j_) * 1024), 16, 0, 0); } while (0)
    asm volatile("s_waitcnt vmcnt(0)" ::: "memory");
    AS_ISSUE(0); AS_ISSUE(1); AS_ISSUE(2);
    for (int t = 0; t < ntile; ++t) {
        asm volatile("s_waitcnt vmcnt(4)" ::: "memory");
        __builtin_amdgcn_s_barrier();
        AS_ISSUE(t + 3);
        const LAS unsigned char* sl = ring + (t & 3) * 16384 + half * 8192 + lane * 16;
        bf16x8 kf[NMAP][NS], vf[2][2];
#pragma unroll
        for (int mp = 0; mp < NMAP; ++mp)
#pragma unroll
            for (int s = 0; s < NS; ++s) kf[mp][s] = *(const LAS bf16x8*)(sl + (mp * NS + s) * 1024);
#pragma unroll
        for (int mt = 0; mt < 2; ++mt)
#pragma unroll
            for (int sp = 0; sp < 2; ++sp) vf[mt][sp] = *(const LAS bf16x8*)(sl + 4096 + (mt * 2 + sp) * 1024);
#pragma unroll
        for (int mp = 0; mp < NMAP; ++mp) {
            f32x16 S;
#pragma unroll
            for (int i = 0; i < 16; ++i) S[i] = 0.f;
#pragma unroll
            for (int s = 0; s < NS; ++s) S = MFMA32(kf[mp][s], qf[mp][s], S);
            float mx = fmaxf(fmaxf(S[0], S[1]), fmaxf(S[2], S[3]));
#pragma unroll
            for (int i = 4; i < 16; i += 4) mx = fmaxf(mx, fmaxf(fmaxf(S[i], S[i + 1]), fmaxf(S[i + 2], S[i + 3])));
            { const auto sw_ = __builtin_amdgcn_permlane32_swap(__builtin_bit_cast(unsigned, mx), __builtin_bit_cast(unsigned, mx), false, false);
              mx = fmaxf(__builtin_bit_cast(float, sw_[0]), __builtin_bit_cast(float, sw_[1])); }
            if (__builtin_amdgcn_ballot_w64(mx > mrun[mp]) != 0ull) {
                const float mn = fmaxf(mrun[mp], mx);
                const float alpha = __builtin_amdgcn_exp2f((mrun[mp] - mn) * cs);
                mrun[mp] = mn; lrun[mp] *= alpha;
                o[mp][0] *= alpha; o[mp][1] *= alpha;
            }
            const float nb = mrun[mp] * cs;
            float ps = 0.f; bf16x8 pa, pb;
            { float pv[8];
#pragma unroll
              for (int i = 0; i < 8; ++i) { pv[i] = __builtin_amdgcn_exp2f(S[i] * cs - nb); ps += pv[i]; } pa = __builtin_bit_cast(bf16x8, pack8(pv)); }
            { float pv[8];
#pragma unroll
              for (int i = 0; i < 8; ++i) { pv[i] = __builtin_amdgcn_exp2f(S[8 + i] * cs - nb); ps += pv[i]; } pb = __builtin_bit_cast(bf16x8, pack8(pv)); }
            lrun[mp] += ps;
#pragma unroll
            for (int mt = 0; mt < 2; ++mt) { o[mp][mt] = MFMA32(vf[mt][0], pa, o[mp][mt]); o[mp][mt] = MFMA32(vf[mt][1], pb, o[mp][mt]); }
        }
    }
    asm volatile("s_waitcnt vmcnt(0)" ::: "memory");
    __builtin_amdgcn_s_barrier();
#undef AS_ISSUE
}

template <int TYPE>
DI void attn_item(const Params& p, int l, int lat, int b, int head, int qt, int part, int nparts, LAS float* xch, bool combine, int lane, int wave, LAS unsigned char* lds) {
    constexpr int NMAP = TYPE == 0 ? 1 : 2;
    constexpr int DQK = TYPE == 0 ? 64 : 32;
    unsigned char* ws = p.ws;
    unsigned char* att = ws + WS_ATT;
    bf16_t* br = (bf16_t*)(ws + WS_BR);
    const int r = lane & 31, h = lane >> 5;
    const int token0 = (lat ? TC + b * 2048 : b * 256) + qt * 32;
    const int nkeys = lat ? 2560 : 256;
    const int kb = part * (nkeys / nparts), ke = kb + nkeys / nparts;
    const bf16_t *Q, *K, *VT; size_t kms = 0; float cs; int ldq = 256;
    if (TYPE == 0) {
        const int hk = head >> 1;
        Q = (const bf16_t*)(att + A_QB) + (size_t)token0 * 256 + head * 64;
        K = lat ? (const bf16_t*)(att + A_KBL) + (size_t)(b * 2 + hk) * 2560 * 64 : (const bf16_t*)(att + A_KBC) + (size_t)(b * 2 + hk) * 256 * 64;
        VT = lat ? (const bf16_t*)(att + A_VBL) + (size_t)(b * 2 + hk) * 64 * 2560 : (const bf16_t*)(att + A_VBC) + (size_t)(b * 2 + hk) * 64 * 256;
        cs = 0.125f * 1.4426950408889634f;
    } else {
        if (lat) Q = (const bf16_t*)(att + A_QC) + (size_t)token0 * 256 + head * 64;
        else { Q = (const bf16_t*)(ws + WS_PROJ) + (size_t)token0 * NPROJ + 512 + head * 64; ldq = NPROJ; }
        K = lat ? (const bf16_t*)(att + A_KCL) + (size_t)(b * 8 + head * 2) * 2560 * 32 : (const bf16_t*)(att + A_KCC) + (size_t)(b * 8 + head * 2) * 256 * 32;
        VT = lat ? (const bf16_t*)(att + A_VCL) + (size_t)(b * 4 + head) * 64 * 2560 : (const bf16_t*)(att + A_VCC) + (size_t)(b * 4 + head) * 64 * 256;
        kms = (size_t)nkeys * 32; cs = 0.17677669529663687f * 1.4426950408889634f;
    }
    f32x16 o[NMAP][2]; float mr[NMAP], lr[NMAP];
    if (combine) attn_core_staged<DQK, NMAP>(Q, K, kms, VT, part, nkeys / (32 * nparts), cs, o, mr, lr, lane, wave, lds);
    else attn_core<DQK, NMAP>(Q, ldq, K, kms, VT, kb, ke, cs, o, mr, lr, lane);
    if (combine) {
        if (part == 1) {
#pragma unroll
            for (int mp = 0; mp < NMAP; ++mp) {
#pragma unroll
                for (int mt = 0; mt < 2; ++mt)
#pragma unroll
                    for (int i = 0; i < 16; ++i) xch[((mp * 2 + mt) * 16 + i) * 64 + lane] = o[mp][mt][i];
                xch[(64 + mp * 2) * 64 + lane] = mr[mp]; xch[(65 + mp * 2) * 64 + lane] = lr[mp];
            }
        }
        __syncthreads();
        if (part == 1) return;
#pragma unroll
        for (int mp = 0; mp < NMAP; ++mp) {
            const float m2 = xch[(64 + mp * 2) * 64 + lane], l2 = xch[(65 + mp * 2) * 64 + lane];
            const float mn = fmaxf(mr[mp], m2), a1 = __builtin_amdgcn_exp2f((mr[mp] - mn) * cs), a2 = __builtin_amdgcn_exp2f((m2 - mn) * cs);
            lr[mp] = lr[mp] * a1 + l2 * a2;
#pragma unroll
            for (int mt = 0; mt < 2; ++mt)
#pragma unroll
                for (int i = 0; i < 16; ++i) o[mp][mt][i] = o[mp][mt][i] * a1 + xch[((mp * 2 + mt) * 16 + i) * 64 + lane] * a2;
        }
    }
    float ls[NMAP];
#pragma unroll
    for (int mp = 0; mp < NMAP; ++mp) ls[mp] = lr[mp] + __shfl_xor(lr[mp], 32);
    if (TYPE == 0) {
        const float inv = 1.f / ls[0];
        bf16_t* dst = br + (size_t)(token0 + r) * 1280 + 512 + head * 64;
#pragma unroll
        for (int mt = 0; mt < 2; ++mt)
#pragma unroll
            for (int g4 = 0; g4 < 4; ++g4) { u32x2 w; w.x = cvtpk(o[0][mt][4 * g4] * inv, o[0][mt][4 * g4 + 1] * inv); w.y = cvtpk(o[0][mt][4 * g4 + 2] * inv, o[0][mt][4 * g4 + 3] * inv);
                *(u32x2*)(dst + 32 * mt + 8 * g4 + 4 * h) = w; }
    } else {
        const float lam = ((const float*)(ws + CTL_LAM))[l];
        const float lam_scale = 1.f - (0.8f - 0.6f * expf(-0.3f * (float)l));
        const float i0 = 1.f / ls[0], i1 = lam / ls[NMAP - 1];
        float ss = 0.f;
#pragma unroll
        for (int mt = 0; mt < 2; ++mt)
#pragma unroll
            for (int i = 0; i < 16; ++i) { const float v = o[0][mt][i] * i0 - o[NMAP - 1][mt][i] * i1; o[0][mt][i] = v; ss += v * v; }
        ss += __shfl_xor(ss, 32);
        const float rn = rsqrtf(ss * (1.f / 64.f) + EPS) * lam_scale;
        const float* dg = p.in[20] + l * 64;
        bf16_t* dst = br + (size_t)(token0 + r) * 1280 + 768 + head * 64;
#pragma unroll
        for (int mt = 0; mt < 2; ++mt)
#pragma unroll
            for (int g4 = 0; g4 < 4; ++g4) { const int d0 = 32 * mt + 8 * g4 + 4 * h; const f32x4 g = *(const f32x4*)(dg + d0);
                u32x2 w; w.x = cvtpk(o[0][mt][4 * g4] * rn * g[0], o[0][mt][4 * g4 + 1] * rn * g[1]); w.y = cvtpk(o[0][mt][4 * g4 + 2] * rn * g[2], o[0][mt][4 * g4 + 3] * rn * g[3]);
                *(u32x2*)(dst + d0) = w; }
    }
}

DI void attn_phase(const Params& p, int l, LAS unsigned char* lds) {
    const int tid_ = opaque_v(TIDX), lane = tid_ & 63, wave = __builtin_amdgcn_readfirstlane(tid_ >> 6);
    const int bx = blockIdx.x;
    const int bb = bx - 32;
    LAS float* xch = (LAS float*)lds + (wave & 3) * (68 * 64);
    { int n0 = -1, nstep = 0, ncnt = 0;
      if (bx < 32) { n0 = bx * 8 + wave; nstep = 256; ncnt = 2; }
      else if (bb >= 160) { n0 = 512 + (bb - 160) * 8 + wave; nstep = 512; ncnt = 3; }
      if (bx < 32) {
        for (int j = 0; j < ncnt; ++j) { const int n = n0 + j * nstep, i2 = n;
            const int type = i2 >> 10, rem = i2 & 1023, b = rem >> 5, head = (rem >> 3) & 3, qt = rem & 7;
            if (type == 0) attn_item<0>(p, l, 0, b, head, qt, 0, 1, xch, false, lane, wave, lds);
            else attn_item<1>(p, l, 0, b, head, qt, 0, 1, xch, false, lane, wave, lds); }
        return;
      }
    }
    for (int round = 0; round < 2; ++round) {
        if (round == 1 && (bb < 128 || bb >= 160)) break;
        const int q = bb * 4 + (wave & 3);
        int type, ii;
        if (round == 0) { type = q < 512 ? 1 : 0; ii = q < 512 ? q : q - 512; }
        else { type = 0; ii = 384 + (bb - 128) * 4 + (wave & 3); }
        const int b = ii >> 8, head = (ii >> 6) & 3, qt = ii & 63;
        if (type == 0) attn_item<0>(p, l, 1, b, head, qt, wave >> 2, 2, xch, true, lane, wave, lds);
        else attn_item<1>(p, l, 1, b, head, qt, wave >> 2, 2, xch, true, lane, wave, lds);
        __syncthreads();
    }
    if (bb >= 160)
    for (int j = 0; j < 3; ++j) { const int n = 512 + (bb - 160) * 8 + wave + j * 512, i2 = n;
        const int type = i2 >> 10, rem = i2 & 1023, b = rem >> 5, head = (rem >> 3) & 3, qt = rem & 7;
        if (type == 0) attn_item<0>(p, l, 0, b, head, qt, 0, 1, xch, false, lane, wave, lds);
        else attn_item<1>(p, l, 0, b, head, qt, 0, 1, xch, false, lane, wave, lds);
    }
}

#define XB_TMO      128
#define XB_XCNT(j)  (256  + 64 * (j))
#define XB_XSUB(j)  (1280 + 64 * (j))
#define XB_XGEN(j)  (2304 + 64 * (j))
#define XB_TOP      3328
#define XB_TOPGEN   3392
#define XCD_BAR_WORDS 3456
#define XB_SPIN_CAP (1u << 20)
DI unsigned xb_ld(unsigned* p)              { return __hip_atomic_load(p, __ATOMIC_RELAXED, __HIP_MEMORY_SCOPE_AGENT); }
DI unsigned xb_add(unsigned* p, unsigned v) { return __hip_atomic_fetch_add(p, v, __ATOMIC_RELAXED, __HIP_MEMORY_SCOPE_AGENT); }
DI unsigned xb_xcc_id() { return (unsigned)__builtin_amdgcn_s_getreg((3 << 11) | 20) & 0xFu; }
#define XB_SPIN(cond, bar) do { unsigned _sp = 0; while (cond) { __builtin_amdgcn_s_sleep(1); \
    if ((++_sp & 255u) == 0u) { if (xb_ld(&(bar)[XB_TMO])) break; if (_sp > XB_SPIN_CAP) { atomicAdd(&(bar)[XB_TMO], 1u); break; } } } } while (0)
struct XcdBarrier { unsigned* bar; unsigned x; volatile LAS unsigned* st; };
DI XcdBarrier xcd_barrier_post(unsigned* bar, volatile LAS unsigned* st) {
    XcdBarrier b; b.bar = bar; b.x = xb_xcc_id(); b.st = st;
    if (TIDX == 0) (void)xb_add(&bar[XB_XCNT(b.x)], 1u);
    return b;
}
DI void xcd_barrier_complete(unsigned* bar, unsigned x, unsigned& nloc, unsigned& nx) {
    const unsigned G = gridDim.x * gridDim.y * gridDim.z;
    unsigned sum, cnt, mine, sp = 0u;
    for (;;) {
        sum = 0u; cnt = 0u; mine = 0u;
#pragma unroll
        for (unsigned j = 0; j < 16; ++j) { const unsigned c = xb_ld(&bar[XB_XCNT(j)]); sum += c; cnt += (c > 0u) ? 1u : 0u; mine = (j == x) ? c : mine; }
        if (sum == G) break;
        __builtin_amdgcn_s_sleep(1);
        if ((++sp & 255u) == 0u) { if (xb_ld(&bar[XB_TMO])) break; if (sp > XB_SPIN_CAP) { atomicAdd(&bar[XB_TMO], 1u); break; } }
    }
    nloc = mine > 0u ? mine : 1u; nx = cnt > 0u ? cnt : 1u;
}
DI void xcd_barrier(const XcdBarrier& b) {
    asm volatile("s_waitcnt vmcnt(0)" ::: "memory");
    __syncthreads();
    if (TIDX == 0) {
        unsigned* bar = b.bar;
        __builtin_amdgcn_s_waitcnt(0);
        unsigned nloc = b.st[0], nx = b.st[1];
        if (nloc == 0u) { xcd_barrier_complete(bar, b.x, nloc, nx); b.st[0] = nloc; b.st[1] = nx; }
        const unsigned old = xb_add(&bar[XB_XSUB(b.x)], 1u);
        const unsigned gen = old / nloc;
        if (old + 1u == (gen + 1u) * nloc) {
            __builtin_amdgcn_fence(__ATOMIC_RELEASE, "agent");
            asm volatile("s_waitcnt vmcnt(0)" ::: "memory");
            const unsigned og = xb_add(&bar[XB_TOP], 1u);
            const unsigned tg = og / nx;
            if (og + 1u == (tg + 1u) * nx) xb_add(&bar[XB_TOPGEN], 1u);
            else XB_SPIN(xb_ld(&bar[XB_TOPGEN]) == tg, bar);
            __builtin_amdgcn_fence(__ATOMIC_ACQUIRE, "agent");
            xb_add(&bar[XB_XGEN(b.x)], 1u);
            asm volatile("s_waitcnt vmcnt(0)" ::: "memory");
        } else {
            XB_SPIN(xb_ld(&bar[XB_XGEN(b.x)]) == gen, bar);
            __builtin_amdgcn_fence(__ATOMIC_ACQUIRE, "agent");
            asm volatile("s_waitcnt vmcnt(0)" ::: "memory");
        }
    }
    __syncthreads();
}

__global__ void __launch_bounds__(NWAVES * 64, 2) mega_fwd(Params p) {
    extern __shared__ __attribute__((aligned(16))) unsigned char lds_raw[];
    LAS unsigned char* lds = (LAS unsigned char*)lds_raw;
    cg::grid_group grid = cg::this_grid();
    const int G = gridDim.x, bx = blockIdx.x;
    unsigned char* ws = p.ws;

    { const unsigned hw_ = (unsigned)__builtin_amdgcn_s_getreg((5 << 11) | 4) & 63u; ((volatile LAS int*)(131072 + 64))[hw_] = (int)(__builtin_amdgcn_workitem_id_x() >> 6); }
    __syncthreads();
    volatile LAS unsigned* bst = (volatile LAS unsigned*)(lds + 131072);
    if (TIDX == 0) { bst[0] = 0u; bst[1] = 0u; }
    if (bx == 0 && TIDX < 64) for (int i = TIDX; i < 8192; i += 64) ((unsigned*)(ws + CTL_BAR))[i] = 0u;
    asm volatile("s_waitcnt vmcnt(0)" ::: "memory");
    grid.sync();
    (void)xcd_barrier_post((unsigned*)(ws + CTL_BAR), bst);
#define XBAR() do { XcdBarrier xb_; xb_.bar = (unsigned*)(p.ws + CTL_BAR); xb_.x = xb_xcc_id(); xb_.st = (volatile LAS unsigned*)(lds + 131072); xcd_barrier(xb_); } while (0)
    prologue(p, lds, 0, 4, bx, G, true);
    XBAR();
    for (int st = 0; st < 36; ++st) {
        const int l = st / 9, k = st % 9;
        if (k == 0 || k == 6) norm_phase(p, l, k == 0 ? 0 : 1);
        else if (k == 2) pp_phase(p, l);
        else {
            const int j0 = k == 1 ? J_G1A : k == 3 ? J_DFTL : k == 4 ? J_G2 : k == 5 ? J_G3 : k == 7 ? J_G4 : J_G5;
            const int j1 = k == 1 ? J_G1B : k == 3 ? J_SGU : j0;
            unsigned char* wl = ws + WS_W + (size_t)l * W_LAYER;
            for (int job = j0; job <= j1; ++job) {
                Sched S; S.job = job; S.G = G; S.c = bx; S.nM = 48; S.nN = 4; S.nt = 16; S.lda = 1024; S.ldb = 1024;
                switch (job) {
                case J_G1A: S.A = (const char*)(ws + WS_H); S.B = (const char*)(wl + W_CAT); S.nN = 23; break;
                case J_G1B: S.A = (const char*)(wl + W_A); S.B = (const char*)(ws + WS_H); S.nM = 2; S.nN = 48; S.c = (bx - 80 + G) % G; break;
                case J_DFTL: S.A = (const char*)(ws + WS_FLAT); S.B = (const char*)(ws + WS_ZTL); S.lda = 4096; S.ldb = 4096; S.nM = 16; S.nN = 2; break;
                case J_DFTC: S.A = (const char*)(ws + WS_FCTX); S.B = (const char*)(ws + WS_ZTC); S.lda = 512; S.ldb = 512; S.nM = 32; S.nN = 2; S.c = (bx - 32 + G) % G; break;
                case J_SGU: S.A = (const char*)(wl + W_SP); S.B = (const char*)(ws + WS_DVT); S.lda = 256; S.ldb = 256; S.nM = 2; S.nN = 24; S.c = (bx - 96 + G) % G; break;
                case J_G2: S.A = (const char*)(ws + WS_BR); S.B = (const char*)(wl + W_BALL); S.lda = 1280; S.ldb = 1280; break;
                case J_G3: S.A = (const char*)(ws + WS_MERGED); S.B = (const char*)(wl + W_OUT); break;
                case J_G4: S.A = (const char*)(ws + WS_H); S.B = (const char*)(wl + W_1); S.nN = 16; break;
                default: S.A = (const char*)(ws + WS_GATES); S.B = (const char*)(wl + W_2); S.lda = 4096; S.ldb = 4096; S.nt = 64; break;
                }
                S.nwg = S.nM * S.nN;
                const Epi E{job, l, p};
                pg8::gemm_phase<Epi, Sched>(lds, S.lda, S.ldb, S, E);
            }
            if (k == 3) attn_phase(p, l, lds);
        }
        XBAR();
    }
    norm_phase(p, 0, 2);
}

extern "C" void kernel_launch(void* const* d_in, const int* in_sizes, int n_in, void* d_out, int out_size, void* d_ws, size_t ws_size, hipStream_t stream) {
    static int grid = 0;
    constexpr int LDS_BYTES = 131072 + 1024;
    if (grid == 0) {
        if (n_in != 30 || ws_size < WS_END) { fprintf(stderr, "kernel_launch: n_in %d ws %zu (need %zu)\n", n_in, ws_size, (size_t)WS_END); grid = -1; return; }
        int dev = 0, cus = 0, per_cu = 0;
        (void)hipGetDevice(&dev);
        (void)hipDeviceGetAttribute(&cus, hipDeviceAttributeMultiprocessorCount, dev);
        (void)hipFuncSetAttribute((const void*)mega_fwd, hipFuncAttributeMaxDynamicSharedMemorySize, LDS_BYTES);
        (void)hipOccupancyMaxActiveBlocksPerMultiprocessor(&per_cu, (const void*)mega_fwd, NWAVES * 64, LDS_BYTES);
        if (per_cu < 1) per_cu = 1;
        grid = cus;
        (void)hipGetLastError();
    }
    if (grid < 0) return;
    Params prm{};
    for (int i = 0; i < 30; ++i) prm.in[i] = (const float*)d_in[i];
    prm.out = (float*)d_out; prm.ws = (unsigned char*)d_ws;
    void* args[] = {&prm};
    hipError_t e = hipLaunchCooperativeKernel((const void*)mega_fwd, dim3(grid), dim3(NWAVES * 64), args, LDS_BYTES, stream);
    if (e != hipSuccess) fprintf(stderr, "cooperative launch failed: %s (grid %d)\n", hipGetErrorString(e), grid);
}
```

```cpp
#include <hip/hip_runtime.h>
#include <hip/hip_cooperative_groups.h>
#include <cstdio>
#include <cstdint>
namespace cg = cooperative_groups;

#define LAS __attribute__((address_space(3)))
#define DI __device__ __forceinline__
typedef unsigned short bf16_t;
typedef short bf16x8 __attribute__((ext_vector_type(8)));
typedef short s16x4 __attribute__((ext_vector_type(4)));
typedef float f32x4 __attribute__((ext_vector_type(4)));
typedef float f32x16 __attribute__((ext_vector_type(16)));
typedef unsigned u32x4 __attribute__((ext_vector_type(4)));
typedef unsigned u32x2 __attribute__((ext_vector_type(2)));
typedef __bf16 bf16x2_t __attribute__((ext_vector_type(2)));
typedef float f32x2_t __attribute__((ext_vector_type(2)));

constexpr int T = 12288, TC = 8192, DM = 1024, NPROJ = 1792;
constexpr int NWAVES = 8;
constexpr float EPS = 1e-6f;

constexpr size_t MiB = 1u << 20;
constexpr size_t CTL_BYTES = 1 * MiB;
constexpr size_t CTL_CTR = 0;
constexpr size_t CTL_MOD = 65536;
constexpr size_t CTL_LAM = CTL_MOD + 294912;
constexpr size_t CTL_FLAG = 524288 + 16384;
constexpr size_t CTL_BAR = 524288;
constexpr size_t WS_W = 1 * MiB;
constexpr size_t W_CAT = 0, W_A = W_CAT + 12058624, W_BALL = W_A + 1048576, W_OUT = W_BALL + 2621440, W_1 = W_OUT + 2097152,
                 W_2 = W_1 + 8388608, W_SP = W_2 + 8388608, W_LAYER = W_SP + 262144;
constexpr size_t WS_FCTX = WS_W + 4 * W_LAYER;
constexpr size_t WS_FLAT = WS_FCTX + 262144;
constexpr size_t WS_GATES = WS_FLAT + 16777216;
constexpr size_t WS_H = WS_GATES + 100663296;
constexpr size_t WS_PROJ = WS_H + 25165824;
constexpr size_t WS_S = WS_H;
constexpr size_t WS_BR = WS_PROJ + 44040192;
constexpr size_t WS_ZTC = WS_BR + 31457280;
constexpr size_t WS_ZTL = WS_ZTC + 8388608;
constexpr size_t WS_ATT = WS_ZTL + 4194304;
constexpr size_t A_QB = 0, A_KBC = 6291456, A_KBL = 8388608, A_VBC = 9699328, A_VBL = 11796480, A_QC = 13107200, A_KCC = 19398656,
                 A_KCL = 23592960, A_VCC = 26214400, A_VCL = 30408704, A_END = 33030144;
constexpr size_t WS_MERGED = WS_ATT;
constexpr size_t WS_DVT = WS_ATT + A_END;
constexpr size_t WS_END = WS_DVT + 6291456;
static_assert(WS_S + 50331648 <= WS_BR, "S overlay");
static_assert(25165824 <= A_END, "merged overlay");

constexpr size_t O_GK = 12582912, O_GV = 16777216, O_DK = 20971520, O_DV = 29360128;

struct Params { const float* in[30]; float* out; unsigned char* ws; };

DI unsigned cvtpk(float lo, float hi) { f32x2_t v = {lo, hi}; bf16x2_t b = __builtin_convertvector(v, bf16x2_t); return __builtin_bit_cast(unsigned, b); }
DI float bflo(unsigned u) { return __builtin_bit_cast(float, u << 16); }
DI float bfhi(unsigned u) { return __builtin_bit_cast(float, u & 0xffff0000u); }
DI void unpack8(u32x4 w, float* f) { f[0] = bflo(w.x); f[1] = bfhi(w.x); f[2] = bflo(w.y); f[3] = bfhi(w.y); f[4] = bflo(w.z); f[5] = bfhi(w.z); f[6] = bflo(w.w); f[7] = bfhi(w.w); }
DI u32x4 pack8(const float* f) { u32x4 w; w.x = cvtpk(f[0], f[1]); w.y = cvtpk(f[2], f[3]); w.z = cvtpk(f[4], f[5]); w.w = cvtpk(f[6], f[7]); return w; }
DI float sigmoidf_(float v) { return __builtin_amdgcn_rcpf(1.f + __expf(-v)); }
DI float gelu_tanh(float v) { return v * sigmoidf_(1.5957691216057308f * (v + 0.044715f * v * v * v)); }
DI int fast_tid() {
    const unsigned hw = (unsigned)__builtin_amdgcn_s_getreg((5 << 11) | 4) & 63u;
    const int wv = ((const volatile LAS int*)(131072 + 64))[hw];
    return __builtin_amdgcn_readfirstlane(wv) * 64 + (int)__builtin_amdgcn_mbcnt_hi(~0u, __builtin_amdgcn_mbcnt_lo(~0u, 0u));
}
#define TIDX fast_tid()
DI int opaque_v(int x) { asm volatile("" : "+v"(x)); return x; }
DI float wave_sum(float v) {
#pragma unroll
    for (int o = 1; o < 64; o <<= 1) v += __shfl_xor(v, o);
    return v;
}

namespace pg8 {
constexpr int BM = 256, BK = 64, HALF = 128, HTB = HALF * BK * 2, STAGE_BYTES = 8 * HTB;
DI int lds_byte(int r, int c) { const int st = (r >> 4) * 2 + (c >> 5), rr = r & 15, cc = c & 31, ob = rr * 64 + cc * 2; return st * 1024 + (ob ^ (((ob >> 9) & 1) << 5)); }
DI void stage_rc(int b, int& R, int& C) { const int st = b / 1024, sb = b % 1024, swz = sb ^ (((sb >> 9) & 1) << 5); R = (st >> 1) * 16 + swz / 64; C = (st & 1) * 32 + (swz % 64) / 2; }
DI int perm32(int rho) { const int n = rho >> 4, i = rho & 15; return 8 * (i >> 2) + 4 * n + (i & 3); }

struct Unit { const char* A; const char* B; int nt, r0, c0, z, keep; };

template <class Epi, class Sched>
DI void gemm_phase(LAS unsigned char* lds, const int lda, const int ldb, const Sched& S, const Epi& E) {
    const int tid = opaque_v(TIDX), wid = __builtin_amdgcn_readfirstlane(tid >> 6), lane = tid & 63, wr = wid >> 2, wc = wid & 3, fr = lane & 15, fq = lane >> 4;
    unsigned voffA[2], voffB[2];
#pragma unroll
    for (int i = 0; i < 2; ++i) { int R, C; stage_rc(tid * 16 + i * 8192, R, C); const int Rb = (R & ~31) + perm32(R & 31);
        voffA[i] = (unsigned)(R * lda + C) * 2u; voffB[i] = (unsigned)(Rb * ldb + C) * 2u; }
    const size_t kstep = (size_t)(BK * 2);
    const size_t hstepA = (size_t)HALF * lda * 2, hstepB = (size_t)HALF * ldb * 2;
    const unsigned ldsw = (unsigned)wid * 1024u;
    const int aoff = lds_byte(wr * 64 + fr, fq * 8), boff = lds_byte(wc * 32 + fr, fq * 8);
#define PG8_SA(b, h) (((b) * 2 + (h)) * HTB)
#define PG8_SB(b, h) ((4 + (b) * 2 + (h)) * HTB)
#define PG8_STAGE(bufoff, gbase, voff) do { _Pragma("unroll") for (int _i = 0; _i < 2; ++_i) \
        __builtin_amdgcn_global_load_lds((const unsigned*)((const char*)(gbase) + (voff)[_i]), (LAS unsigned*)(lds + (bufoff) + ldsw + _i * 8192), 16, 0, 0); } while (0)
#define PG8_LDA(dst, b, h) do { _Pragma("unroll") for (int m = 0; m < 4; ++m) _Pragma("unroll") for (int k = 0; k < 2; ++k) dst[m][k] = *(const LAS bf16x8*)(lds + PG8_SA(b, h) + aoff + m * 2048 + k * 1024); } while (0)
#define PG8_LDB(dst, b, h) do { _Pragma("unroll") for (int n = 0; n < 2; ++n) _Pragma("unroll") for (int k = 0; k < 2; ++k) dst[n][k] = *(const LAS bf16x8*)(lds + PG8_SB(b, h) + boff + n * 2048 + k * 1024); } while (0)
#define PG8_MMA(ai, bj, At, Bt) do { __builtin_amdgcn_s_setprio(1); _Pragma("unroll") for (int m = 0; m < 4; ++m) _Pragma("unroll") for (int n = 0; n < 2; ++n) _Pragma("unroll") for (int k = 0; k < 2; ++k) \
        acc[ai][bj][m][n] = __builtin_amdgcn_mfma_f32_16x16x32_bf16(Bt[n][k], At[m][k], acc[ai][bj][m][n], 0, 0, 0); __builtin_amdgcn_s_setprio(0); } while (0)
#define PG8_WAIT_V(n) asm volatile("s_waitcnt vmcnt(" #n ")" ::: "memory")
#define PG8_WAIT_L(n) asm volatile("s_waitcnt lgkmcnt(" #n ")" ::: "memory")
#define PG8_BAR __builtin_amdgcn_s_barrier()
#define PG8_SCHED __builtin_amdgcn_sched_barrier(0)
    Unit cur, nxt; int ui = 0;
    if (!S.next(0, cur)) return;
    f32x4 acc[2][2][4][2];
#pragma unroll
    for (int a = 0; a < 2; ++a)
#pragma unroll
        for (int b = 0; b < 2; ++b)
#pragma unroll
            for (int m = 0; m < 4; ++m)
#pragma unroll
                for (int n = 0; n < 2; ++n) acc[a][b][m][n] = (f32x4){0.f, 0.f, 0.f, 0.f};
    bf16x8 At[4][2], B0[2][2], B1[2][2];
    const char* cA = cur.A; const char* cB = cur.B;
    PG8_STAGE(PG8_SB(0, 0), cB, voffB); PG8_STAGE(PG8_SB(0, 1), cB + hstepB, voffB); PG8_STAGE(PG8_SA(0, 0), cA, voffA); PG8_STAGE(PG8_SA(0, 1), cA + hstepA, voffA);
    if (wr == 1) PG8_BAR;
    PG8_WAIT_V(2); PG8_BAR;
    PG8_STAGE(PG8_SB(1, 0), cB + kstep, voffB); PG8_STAGE(PG8_SA(1, 0), cA + kstep, voffA); PG8_STAGE(PG8_SB(1, 1), cB + hstepB + kstep, voffB);
    PG8_WAIT_V(6); PG8_BAR;
    for (;;) {
        const bool has_next = S.next(ui + 1, nxt);
        const char* nA = has_next ? nxt.A : cA; const char* nB = has_next ? nxt.B : cB;
        const int nt = cur.nt;
        for (int t = 0; t < nt; t += 2) {
            const bool last = (t == nt - 2);
            const char* a1 = cA + (size_t)(t + 1) * kstep;
            const char* a2 = last ? nA : cA + (size_t)(t + 2) * kstep; const char* b2 = last ? nB : cB + (size_t)(t + 2) * kstep;
            const char* a3 = a2 + kstep; const char* b3 = b2 + kstep;
            PG8_LDB(B0, 0, 0); PG8_LDB(B1, 0, 1); PG8_SCHED; PG8_LDA(At, 0, 0); PG8_STAGE(PG8_SA(1, 1), a1 + hstepA, voffA);
            PG8_WAIT_V(8); PG8_WAIT_L(0); PG8_BAR; PG8_MMA(0, 0, At, B0); PG8_MMA(0, 1, At, B1); PG8_BAR; PG8_SCHED;
            PG8_LDA(At, 0, 1); PG8_STAGE(PG8_SB(0, 0), b2, voffB); PG8_STAGE(PG8_SB(0, 1), b2 + hstepB, voffB); PG8_STAGE(PG8_SA(0, 0), a2, voffA);
            PG8_WAIT_V(8); PG8_WAIT_L(0); PG8_BAR; PG8_MMA(1, 0, At, B0); PG8_MMA(1, 1, At, B1); PG8_BAR; PG8_SCHED;
            PG8_LDB(B0, 1, 0); PG8_LDB(B1, 1, 1); PG8_SCHED; PG8_LDA(At, 1, 0); PG8_STAGE(PG8_SA(0, 1), a2 + hstepA, voffA);
            PG8_WAIT_V(8); PG8_WAIT_L(0); PG8_BAR; PG8_MMA(0, 0, At, B0); PG8_MMA(0, 1, At, B1); PG8_BAR; PG8_SCHED;
            PG8_LDA(At, 1, 1); PG8_STAGE(PG8_SB(1, 0), b3, voffB); PG8_STAGE(PG8_SB(1, 1), b3 + hstepB, voffB); PG8_STAGE(PG8_SA(1, 0), a3, voffA);
            PG8_WAIT_V(8); PG8_WAIT_L(0); PG8_BAR; PG8_MMA(1, 0, At, B0); PG8_MMA(1, 1, At, B1); PG8_BAR; PG8_SCHED;
        }
        if (wr == 0) PG8_BAR;
        { const int ln_ = opaque_v(TIDX) & 63, fr_ = ln_ & 15, fq_ = ln_ >> 4;
        E.pre(acc, cur);
        E(acc, cur, wr, wc, fr_, fq_);
        if (!has_next) break;
        E.scale(acc, cur, wr, wc, fr_, fq_); }
        if (!nxt.keep) {
#pragma unroll
        for (int a = 0; a < 2; ++a)
#pragma unroll
            for (int b = 0; b < 2; ++b)
#pragma unroll
                for (int m = 0; m < 4; ++m)
#pragma unroll
                    for (int n = 0; n < 2; ++n) acc[a][b][m][n] = (f32x4){0.f, 0.f, 0.f, 0.f};
        }
        cur = nxt; cA = nA; cB = nB; ++ui;
        if (wr == 1) PG8_BAR;
    }
    PG8_WAIT_V(0);
    PG8_BAR;
#undef PG8_SA
#undef PG8_SB
#undef PG8_STAGE
#undef PG8_LDA
#undef PG8_LDB
#undef PG8_MMA
#undef PG8_WAIT_V
#undef PG8_WAIT_L
#undef PG8_BAR
#undef PG8_SCHED
}
}

enum { J_G1A = 0, J_G1B, J_DFTL, J_DFTC, J_SGU, J_G2, J_G3, J_G4, J_G5 };

DI void xcd_decode(int L, int nM, int nN, int nwg, int& pm, int& pn) {
    int wgid = L; { const int q = nwg / 8, r = nwg % 8, xcd = wgid % 8, off = wgid / 8; wgid = (xcd < r ? xcd * (q + 1) : r * (q + 1) + (xcd - r) * q) + off; }
    const int nig = 8 * nN, gid = wgid / nig, fm = gid * 8, gsz = (nM - fm) < 8 ? (nM - fm) : 8;
    pm = fm + ((wgid % nig) % gsz); pn = (wgid % nig) / gsz;
}

struct Sched {
    int job, G, c;
    const char* A; const char* B; int lda, ldb, nM, nN, nwg, nt;
    DI bool next(int i, pg8::Unit& u) const {
        if (job == J_G2) {
            if (c >= 192 || i >= 4) return false;
            int pm, pn; xcd_decode(c, 48, 4, 192, pm, pn);
            const int koff = i == 0 ? 0 : 256 + 256 * i;
            u.A = A + ((size_t)pm * 256 * 1280 + koff) * 2; u.B = B + ((size_t)pn * 256 * 1280 + koff) * 2; u.nt = i == 0 ? 8 : 4; u.r0 = pm * 256; u.c0 = pn * 256; u.z = i; u.keep = i > 0;
            return true;
        }
        const long Ll = (long)i * G + c; if (Ll >= nwg && job != J_G5) return false;
        const int L = (int)Ll;
        if (job == J_DFTL) {
            const int b = L >> 4, part = (L >> 3) & 1, pm = L & 7;
            u.A = A + ((size_t)pm * 256 * 4096 + part * 2048) * 2; u.B = B + ((size_t)b * 256 * 4096 + part * 2048) * 2; u.nt = 32;
            u.r0 = TC + b * 2048 + pm * 256; u.c0 = part * 256; u.z = 0; u.keep = 0; return true;
        }
        if (job == J_DFTC) {
            const int b = L >> 1, part = L & 1;
            u.A = A + (size_t)(part * 256) * 2; u.B = B + ((size_t)b * 256 * 512 + part * 256) * 2; u.nt = 4; u.r0 = b * 256; u.c0 = part * 256; u.z = 0; u.keep = 0; return true;
        }
        if (job == J_SGU) {
            const int pair = L / 24, pn = L % 24;
            u.A = A + (size_t)pair * 256 * 256 * 2; u.B = B + ((size_t)pair * 6144 + pn * 256) * 256 * 2; u.nt = 4; u.r0 = 0; u.c0 = pn * 256; u.z = pair; u.keep = 0; return true;
        }
        if (job == J_G5) {
            const int ntm = nt * 3 / 4, nth = nt - ntm;
            int tile, koff, ntu, z;
            if (c < 192) { if (i > 0) return false; tile = c; koff = 0; ntu = ntm; z = 0; }
            else { if (i >= 3) return false; tile = 3 * (c - 192) + i; koff = ntm * 64; ntu = nth; z = 1; }
            int pm, pn; xcd_decode(tile, 48, 4, 192, pm, pn);
            u.A = A + ((size_t)pm * 256 * lda + koff) * 2; u.B = B + ((size_t)pn * 256 * ldb + koff) * 2; u.nt = ntu; u.r0 = pm * 256; u.c0 = pn * 256; u.z = z + 2 * tile; u.keep = 0;
            return true;
        }
        int pm, pn; xcd_decode(L, nM, nN, nwg, pm, pn);
        u.A = A + (size_t)pm * 256 * lda * 2; u.B = B + (size_t)pn * 256 * ldb * 2; u.nt = nt; u.r0 = pm * 256; u.c0 = pn * 256; u.z = 0; u.keep = 0;
        return true;
    }
};

struct Epi {
    int job, l;
    const Params& p;
    DI void operator()(const f32x4 (&acc)[2][2][4][2], const pg8::Unit& u, int wr, int wc, int fr, int fq) const {
        unsigned char* ws = p.ws;
        const int rbase = u.r0 + wr * 64 + fr, cbase = u.c0 + wc * 32 + 8 * fq;
#define EPI_LOOP_AI for (int ai = 0; ai < 2; ++ai) _Pragma("unroll") for (int bj = 0; bj < 2; ++bj)
#define EPI_LOOP_MB _Pragma("unroll") for (int m = 0; m < 4; ++m)
#define EPI_SB asm volatile("" ::: "memory")
#define EPI_RC const int row = rbase + ai * 128 + m * 16, col = cbase + bj * 128; (void)row; (void)col
#define EPI_V float v[8]; _Pragma("unroll") for (int j = 0; j < 4; ++j) { v[j] = acc[ai][bj][m][0][j]; v[4 + j] = acc[ai][bj][m][1][j]; }
        switch (job) {
        case J_G1A: {
            if (u.c0 < NPROJ) {
#pragma unroll
                EPI_LOOP_AI { EPI_LOOP_MB { EPI_RC; EPI_V;
                    if (u.c0 >= 1280) {
#pragma unroll
                        for (int j = 0; j < 8; ++j) v[j] = gelu_tanh(v[j]); }
                    *(u32x4*)((bf16_t*)(ws + WS_PROJ) + (size_t)row * NPROJ + col) = pack8(v); } }
            } else {
#pragma unroll
                EPI_LOOP_AI { EPI_LOOP_MB { EPI_RC; EPI_V;
#pragma unroll
                    for (int j = 0; j < 8; ++j) v[j] = sigmoidf_(v[j]);
                    *(u32x4*)((bf16_t*)(ws + WS_GATES) + (size_t)row * 4096 + (col - NPROJ)) = pack8(v); } }
            }
        } break;
        case J_G1B: {
#pragma unroll
            EPI_LOOP_AI { EPI_LOOP_MB { EPI_RC; EPI_V;
                const int g = row >> 7, cs = (row >> 6) & 1, cp = row & 63, t = col;
                bf16_t* dst;
                if (t < TC) { const int b = t >> 8, k = t & 255; dst = (bf16_t*)(ws + WS_ZTC) + ((size_t)(b * 256 + g * 64 + cp) * 512 + cs * 256 + k); }
                else { const int tl = t - TC, b = tl >> 11, k = tl & 2047; dst = (bf16_t*)(ws + WS_ZTL) + ((size_t)(b * 256 + g * 64 + cp) * 4096 + cs * 2048 + k); }
                *(u32x4*)dst = pack8(v); } }
        } break;
        case J_DFTL: case J_DFTC: {
#pragma unroll
            EPI_LOOP_AI { EPI_LOOP_MB { EPI_RC; EPI_V; *(u32x4*)((bf16_t*)(ws + WS_BR) + (size_t)row * 1280 + col) = pack8(v); } }
        } break;
        case J_SGU: {
            const int q0 = wr * 64 + fr, ch0 = u.z * 128 + (wc & 1) * 32 + 8 * fq, tok0 = ((u.c0 >> 6) + (wc >> 1)) * 128 + q0;
            const bf16_t* dub = (const bf16_t*)(ws + WS_PROJ) + (size_t)tok0 * NPROJ + 1280 + ch0;
            bf16_t* ob = (bf16_t*)(ws + WS_BR) + (size_t)tok0 * 1280 + 1024 + ch0;
            const float* bb = p.in[23] + (l * 4 + u.z * 2) * 128 + q0;
#pragma unroll
            EPI_LOOP_AI {
                EPI_SB; u32x4 duw[4]; float bias[4];
                EPI_LOOP_MB { duw[m] = *(const u32x4*)(dub + (size_t)(bj * 256 + m * 16) * NPROJ + ai * 64); bias[m] = bb[ai * 128 + m * 16]; }
                EPI_LOOP_MB { EPI_V; float du[8]; unpack8(duw[m], du);
#pragma unroll
                    for (int j = 0; j < 8; ++j) v[j] = du[j] * (v[j] + bias[m]);
                    *(u32x4*)(ob + (size_t)(bj * 256 + m * 16) * 1280 + ai * 64) = pack8(v); }
            }
        } break;
        case J_G2: {
            const bf16_t* gbase = (const bf16_t*)(ws + WS_GATES) + u.z * 1024;
            if (u.z == 3) {
#pragma unroll
                EPI_LOOP_AI {
                    EPI_SB; u32x4 g0[4];
                    EPI_LOOP_MB { EPI_RC; g0[m] = *(const u32x4*)(gbase + (size_t)row * 4096 + col); }
                    EPI_LOOP_MB { EPI_RC; EPI_V; float gt[8]; unpack8(g0[m], gt);
#pragma unroll
                        for (int j = 0; j < 8; ++j) v[j] *= gt[j];
                        *(u32x4*)((bf16_t*)(ws + WS_MERGED) + (size_t)row * 1024 + col) = pack8(v); }
                }
            }
        } break;
        case J_G3: case J_G5: {
            const int tile = u.z >> 1;
            unsigned* flag = (unsigned*)(ws + CTL_FLAG) + tile;
            const unsigned want = (unsigned)(2 * l + (job == J_G5 ? 2 : 1));
            const char* ppb = (const char*)(ws + WS_H) + (size_t)tile * 32 * 512 * 16;
            const unsigned pvo = TIDX * 16u;
            if (u.z & 1) {
#pragma unroll
                for (int ai = 0; ai < 2; ++ai)
#pragma unroll
                    for (int bj = 0; bj < 2; ++bj)
#pragma unroll
                        for (int m = 0; m < 4; ++m)
#pragma unroll
                            for (int n = 0; n < 2; ++n) { const unsigned o_ = pvo + (unsigned)((((ai * 2 + bj) * 4 + m) * 2 + n) * 8192); const f32x4 d_ = acc[ai][bj][m][n];
                                asm volatile("global_store_dwordx4 %0, %1, %2 sc0 sc1" :: "v"(o_), "v"(d_), "s"(ppb) : "memory"); }
                asm volatile("s_waitcnt vmcnt(0)" ::: "memory");
                __syncthreads();
                if (TIDX == 0) __hip_atomic_store(flag, want, __ATOMIC_RELAXED, __HIP_MEMORY_SCOPE_AGENT);
                break;
            }
            const int mi = u.r0 < TC ? 0 : 1 + ((u.r0 - TC) >> 11);
            const float* gmod = (const float*)(ws + CTL_MOD) + (size_t)(l * 3 + mi) * 6144 + (job == J_G3 ? 2048 : 5120);
            const bool from_in = (job == J_G3 && l == 0);
            const float* xin = from_in ? (u.r0 < TC ? p.in[0] : p.in[1] - (size_t)TC * 1024) : p.out;
            f32x4 gm[2][2];
#pragma unroll
            for (int bj = 0; bj < 2; ++bj) { gm[bj][0] = *(const f32x4*)(gmod + cbase + bj * 128); gm[bj][1] = *(const f32x4*)(gmod + cbase + bj * 128 + 4); }
#pragma unroll
            EPI_LOOP_AI {
                EPI_SB; f32x4 xv[4][2];
                EPI_LOOP_MB { EPI_RC; const float* xi = xin + (size_t)row * 1024 + col; xv[m][0] = *(const f32x4*)xi; xv[m][1] = *(const f32x4*)(xi + 4); }
                EPI_LOOP_MB { EPI_RC; float* xo = p.out + (size_t)row * 1024 + col;
                    *(f32x4*)xo = xv[m][0] + gm[bj][0] * acc[ai][bj][m][0]; *(f32x4*)(xo + 4) = xv[m][1] + gm[bj][1] * acc[ai][bj][m][1]; }
            }
        } break;
        case J_G4: {
#pragma unroll
            EPI_LOOP_AI { EPI_LOOP_MB { EPI_RC; EPI_V;
#pragma unroll
                for (int j = 0; j < 8; ++j) { const float r = fmaxf(v[j], 0.f); v[j] = r * r; }
                *(u32x4*)((bf16_t*)(ws + WS_GATES) + (size_t)row * 4096 + col) = pack8(v); } }
        } break;
        default: break;
        }
#undef EPI_LOOP_AI
#undef EPI_SB
#undef EPI_LOOP_MB
#undef EPI_RC
#undef EPI_V
    }
    DI void pre(f32x4 (&acc)[2][2][4][2], const pg8::Unit& u) const {
        if (!(job == J_G5 && !(u.z & 1))) return;
        const int tile = u.z >> 1;
        unsigned* flag = (unsigned*)(p.ws + CTL_FLAG) + tile;
        const unsigned want = (unsigned)(2 * l + (job == J_G5 ? 2 : 1));
        const char* ppb = (const char*)(p.ws + WS_H) + (size_t)tile * 32 * 512 * 16;
        const unsigned pvo = TIDX * 16u;
        if (TIDX == 0) { unsigned sp_ = 0; while (__hip_atomic_load(flag, __ATOMIC_RELAXED, __HIP_MEMORY_SCOPE_AGENT) < want) { __builtin_amdgcn_s_sleep(1); if (++sp_ > (1u << 22)) break; } }
        __syncthreads();
#pragma unroll
        for (int ai = 0; ai < 2; ++ai)
#pragma unroll
            for (int bj = 0; bj < 2; ++bj) {
                const unsigned o_ = pvo + (unsigned)(((ai * 2 + bj) * 8) * 8192);
                f32x4 q0, q1, q2, q3, q4, q5, q6, q7;
                asm volatile("global_load_dwordx4 %0, %8, %16 sc0 sc1\n\tglobal_load_dwordx4 %1, %9, %16 sc0 sc1\n\tglobal_load_dwordx4 %2, %10, %16 sc0 sc1\n\tglobal_load_dwordx4 %3, %11, %16 sc0 sc1\n\t"
                             "global_load_dwordx4 %4, %12, %16 sc0 sc1\n\tglobal_load_dwordx4 %5, %13, %16 sc0 sc1\n\tglobal_load_dwordx4 %6, %14, %16 sc0 sc1\n\tglobal_load_dwordx4 %7, %15, %16 sc0 sc1\n\ts_waitcnt vmcnt(0)"
                             : "=&v"(q0), "=&v"(q1), "=&v"(q2), "=&v"(q3), "=&v"(q4), "=&v"(q5), "=&v"(q6), "=&v"(q7)
                             : "v"(o_), "v"(o_ + 8192u), "v"(o_ + 16384u), "v"(o_ + 24576u), "v"(o_ + 32768u), "v"(o_ + 40960u), "v"(o_ + 49152u), "v"(o_ + 57344u), "s"(ppb) : "memory");
                acc[ai][bj][0][0] += q0; acc[ai][bj][0][1] += q1; acc[ai][bj][1][0] += q2; acc[ai][bj][1][1] += q3;
                acc[ai][bj][2][0] += q4; acc[ai][bj][2][1] += q5; acc[ai][bj][3][0] += q6; acc[ai][bj][3][1] += q7;
            }
    }
    DI void scale(f32x4 (&acc)[2][2][4][2], const pg8::Unit& u, int wr, int wc, int fr, int fq) const {
        if (!(job == J_G2 && u.z < 3)) return;
        const bf16_t* gbase = (const bf16_t*)(p.ws + WS_GATES) + u.z * 1024 + (size_t)(u.r0 + wr * 64 + fr) * 4096 + u.c0 + wc * 32 + 8 * fq;
#pragma unroll
        for (int ai = 0; ai < 2; ++ai)
#pragma unroll
            for (int m = 0; m < 4; m += 2) {
                u32x4 g0[2][2], g1[2][2];
#pragma unroll
                for (int mm = 0; mm < 2; ++mm)
#pragma unroll
                    for (int bj = 0; bj < 2; ++bj) { const bf16_t* gp = gbase + (size_t)(ai * 128 + (m + mm) * 16) * 4096 + bj * 128; g0[mm][bj] = *(const u32x4*)gp; g1[mm][bj] = *(const u32x4*)(gp + 1024); }
#pragma unroll
                for (int mm = 0; mm < 2; ++mm)
#pragma unroll
                    for (int bj = 0; bj < 2; ++bj) {
                        float gt[8], gn[8]; unpack8(g0[mm][bj], gt); unpack8(g1[mm][bj], gn);
#pragma unroll
                        for (int j = 0; j < 8; ++j) gt[j] *= __builtin_amdgcn_rcpf(fmaxf(gn[j], 1e-30f));
#pragma unroll
                        for (int j = 0; j < 4; ++j) { acc[ai][bj][m + mm][0][j] *= gt[j]; acc[ai][bj][m + mm][1][j] *= gt[4 + j]; }
                    }
                asm volatile("" ::: "memory");
            }
    }
};

DI void transpose_item(const float* W, int ld, int ncols, bf16_t* WT, int ldw, int koff, int row_off, LAS float* scr, int item, int lane) {
    const int nblk = ncols / 32, kb = item / nblk, nb = item % nblk, k0 = 64 * kb, n0 = 32 * nb;
    float tv[32];
#pragma unroll
    for (int i = 0; i < 32; ++i) { const int kk = 2 * i + (lane >> 5); tv[i] = W[(size_t)(k0 + kk) * ld + n0 + (lane & 31)]; }
#pragma unroll
    for (int i = 0; i < 32; ++i) { const int kk = 2 * i + (lane >> 5); scr[kk * 33 + (lane & 31)] = tv[i]; }
    asm volatile("s_waitcnt lgkmcnt(0)" ::: "memory");
    const int c = lane & 7;
#pragma unroll
    for (int j = 0; j < 4; ++j) { const int n = (lane >> 3) + 8 * j; const LAS float* s = scr + (8 * c) * 33 + n;
        u32x4 o; o.x = cvtpk(s[0 * 33], s[1 * 33]); o.y = cvtpk(s[2 * 33], s[3 * 33]); o.z = cvtpk(s[4 * 33], s[5 * 33]); o.w = cvtpk(s[6 * 33], s[7 * 33]);
        *(u32x4*)(WT + (size_t)(row_off + n0 + n) * ldw + koff + k0 + 8 * c) = o; }
    asm volatile("s_waitcnt lgkmcnt(0)" ::: "memory");
}

DI void prologue(const Params& p, LAS unsigned char* lds, const int lbeg, const int nl, const int vb, const int nvb, const bool common) {
    const int tid_ = opaque_v(TIDX), lane = tid_ & 63, wave = __builtin_amdgcn_readfirstlane(tid_ >> 6), gw = vb * NWAVES + wave, NGW = nvb * NWAVES;
    unsigned char* ws = p.ws;
    LAS float* scr = (LAS float*)(lds + wave * 8448);
    LAS float* tw = (LAS float*)(lds + 8 * 8448);
    if (TIDX < 128) { const int m = TIDX & 63; const float a = (float)m * (2.0f / 64.0f); tw[TIDX] = TIDX < 64 ? cospif(a) : sinpif(a); }
    __syncthreads();
    for (int it = gw; it < nl * 7936; it += NGW) {
        const int l = lbeg + it / 7936; int r = it % 7936;
        unsigned char* wl = ws + WS_W + (size_t)l * W_LAYER;
        if (r < 896) { transpose_item(p.in[12] + (size_t)l * 1024 * 2048 + 256, 2048, 1792, (bf16_t*)(wl + W_CAT), 1024, 0, 0, scr, r, lane); continue; } r -= 896;
        if (r < 2048) { transpose_item(p.in[24] + (size_t)l * 1024 * 4096, 4096, 4096, (bf16_t*)(wl + W_CAT), 1024, 0, 1792, scr, r, lane); continue; } r -= 2048;
        if (r < 384) { const int n = r / 128 + 1; transpose_item(p.in[25] + (size_t)(l * 4 + n) * 256 * 1024, 1024, 1024, (bf16_t*)(wl + W_BALL), 1280, 256 + 256 * n, 0, scr, r % 128, lane); continue; } r -= 384;
        if (r < 512) { transpose_item(p.in[26] + (size_t)l * 1024 * 1024, 1024, 1024, (bf16_t*)(wl + W_OUT), 1024, 0, 0, scr, r, lane); continue; } r -= 512;
        if (r < 2048) { transpose_item(p.in[27] + (size_t)l * 1024 * 4096, 4096, 4096, (bf16_t*)(wl + W_1), 1024, 0, 0, scr, r, lane); continue; } r -= 2048;
        transpose_item(p.in[28] + (size_t)l * 4096 * 1024, 1024, 1024, (bf16_t*)(wl + W_2), 4096, 0, 0, scr, r, lane);
    }
    {
        LAS f32x4* red = (LAS f32x4*)(lds + 69632);
        for (int bi = vb; bi < nl * 24; bi += nvb) {
            const int l = lbeg + bi / 24, cc = bi % 24, n0 = cc * 256 + lane * 4, k0 = wave * 128;
            f32x4 a0 = {0.f, 0.f, 0.f, 0.f}, a1 = a0, a2 = a0;
            const float* wp = p.in[8] + ((size_t)l * 1024 + k0) * 6144 + n0;
#pragma unroll 32
            for (int kk = 0; kk < 128; ++kk) {
                const f32x4 w = *(const f32x4*)(wp + (size_t)kk * 6144);
                const float c0 = p.in[7][k0 + kk], c1 = p.in[2][k0 + kk], c2 = p.in[2][1024 + k0 + kk];
                const float s0 = c0 * sigmoidf_(c0), s1 = c1 * sigmoidf_(c1), s2 = c2 * sigmoidf_(c2);
                a0 += w * s0; a1 += w * s1; a2 += w * s2;
            }
            red[(wave * 3 + 0) * 64 + lane] = a0; red[(wave * 3 + 1) * 64 + lane] = a1; red[(wave * 3 + 2) * 64 + lane] = a2;
            __syncthreads();
            if (TIDX < 192) {
                const int m = TIDX >> 6, ln = TIDX & 63;
                f32x4 sacc = *(const f32x4*)(p.in[9] + (size_t)l * 6144 + cc * 256 + ln * 4);
#pragma unroll
                for (int w = 0; w < 8; ++w) sacc += red[(w * 3 + m) * 64 + ln];
                *(f32x4*)((float*)(ws + CTL_MOD) + (size_t)(l * 3 + m) * 6144 + cc * 256 + ln * 4) = sacc;
            }
            __syncthreads();
        }
    }
    for (int it = (gw >= 1024 ? gw - 1024 : gw + NGW - 1024); it < nl * 128; it += NGW) {
        const int l = lbeg + it / 128, r = it % 128, g = r / 32, cs = (r / 16) & 1, d = (r % 16) * 64 + lane;
        float x[64];
        const float* src = p.in[12] + ((size_t)l * 1024 + d) * 2048 + g * 64;
#pragma unroll
        for (int j = 0; j < 16; ++j) { const f32x4 w = *(const f32x4*)(src + 4 * j); x[4 * j] = w[0]; x[4 * j + 1] = w[1]; x[4 * j + 2] = w[2]; x[4 * j + 3] = w[3]; }
        bf16_t* dst = (bf16_t*)(ws + WS_W + (size_t)l * W_LAYER + W_A) + (size_t)(g * 128 + cs * 64) * 1024 + d;
        for (int cp = 0; cp < 64; ++cp) {
            float a = 0.f;
#pragma unroll
            for (int c = 0; c < 64; ++c) a += x[c] * tw[cs * 64 + ((c * cp) & 63)];
            dst[(size_t)cp * 1024] = (bf16_t)(cvtpk(a * 0.125f, 0.f) & 0xffffu);
        }
    }
    for (int it = gw; it < nl * 512; it += NGW) {
        const int l = lbeg + it / 512, r = it % 512, r0 = (r / 16) * 8, d = (r % 16) * 64 + lane;
        float a[8];
#pragma unroll
        for (int j = 0; j < 8; ++j) a[j] = 0.f;
        const float* wb = p.in[25] + (size_t)(l * 4) * 256 * 1024 + d;
        const float* wf = p.in[13] + ((size_t)l * 256 + r0) * 256;
#pragma unroll 2
        for (int jb = 0; jb < 256; jb += 8) {
            float b[8];
#pragma unroll
            for (int jj = 0; jj < 8; ++jj) b[jj] = wb[(size_t)(jb + jj) * 1024];
#pragma unroll
            for (int rr = 0; rr < 8; ++rr)
#pragma unroll
                for (int jj = 0; jj < 8; ++jj) a[rr] += wf[rr * 256 + jb + jj] * b[jj];
        }
        bf16_t* dst = (bf16_t*)(ws + WS_W + (size_t)l * W_LAYER + W_BALL) + (size_t)d * 1280 + r0;
        const u32x4 o = pack8(a);
        *(u32x4*)dst = o; *(u32x4*)(dst + 256) = o;
    }
    for (int it = gw - (NGW >= 2048 ? 1536 : 0); it >= 0 && it < nl * 256; it += NGW - (NGW >= 2048 ? 1536 : 0)) {
        const int idx = it * 64 + lane, k8 = idx & 31, m = (idx >> 5) & 255, pair = (idx >> 13) & 1, l = lbeg + (idx >> 14);
        const int gsel = m >> 7, q = m & 127, ksel = k8 >> 4, p0 = (k8 & 15) * 8;
        u32x4 o = {0u, 0u, 0u, 0u};
        if (gsel == ksel) { const float* s = p.in[22] + ((size_t)(l * 4 + pair * 2 + gsel) * 128 + q) * 128 + p0; float f[8];
#pragma unroll
            for (int j = 0; j < 8; ++j) f[j] = s[j];
            o = pack8(f); }
        *(u32x4*)((bf16_t*)(ws + WS_W + (size_t)l * W_LAYER + W_SP) + ((size_t)pair * 256 + m) * 256 + k8 * 8) = o;
    }
    if (common)
    for (int it = gw; it < 256 + 16384; it += NGW) {
        const bool ctx = it < 256;
        const int idx = (ctx ? it : it - 256) * 64 + lane;
        const int L = ctx ? 256 : 2048, c8n = ctx ? 64 : 512;
        const int j = idx / c8n, kk0 = (idx % c8n) * 8;
        const float sc = ctx ? 0.0625f : 0.022097086912079608f;
        float f[8];
#pragma unroll
        for (int e = 0; e < 8; ++e) { const int kk = kk0 + e, part = kk >= L, k = kk & (L - 1), mm = (j * k) & (L - 1);
            const float a = (float)(2 * mm) / (float)L; f[e] = (part ? -sinpif(a) : cospif(a)) * sc; }
        *(u32x4*)((bf16_t*)(ws + (ctx ? WS_FCTX : WS_FLAT)) + (size_t)j * (2 * L) + kk0) = pack8(f);
    }
    if (common && blockIdx.x == 0 && TIDX < 4) {
        const int l = TIDX; float s1 = 0.f, s2 = 0.f;
        for (int i = 0; i < 32; ++i) { s1 += p.in[16][l * 32 + i] * p.in[17][l * 32 + i]; s2 += p.in[18][l * 32 + i] * p.in[19][l * 32 + i]; }
        const float lam_init = 0.8f - 0.6f * expf(-0.3f * (float)l);
        ((float*)(ws + CTL_LAM))[l] = expf(s1) - expf(s2) + lam_init;
    }
}

DI void norm_phase(const Params& p, int l, int which) {
    const int tid_ = opaque_v(TIDX), lane = tid_ & 63, wave = __builtin_amdgcn_readfirstlane(tid_ >> 6), gw = blockIdx.x * NWAVES + wave, NGW = gridDim.x * NWAVES;
    unsigned char* ws = p.ws;
    constexpr int KR = 6;
    const float* gg = (which == 0 ? p.in[10] + l * 1024 : which == 1 ? p.in[11] + l * 1024 : p.in[29]);
    for (int row0 = gw; row0 < T; row0 += KR * NGW) {
        f32x4 v[KR][4]; float ss[KR];
#pragma unroll
        for (int k = 0; k < KR; ++k) { const int row = row0 + k * NGW < T ? row0 + k * NGW : row0;
            const float* xr = (l == 0 && which == 0) ? (row < TC ? p.in[0] + (size_t)row * 1024 : p.in[1] + (size_t)(row - TC) * 1024) : p.out + (size_t)row * 1024;
#pragma unroll
            for (int j = 0; j < 4; ++j) v[k][j] = *(const f32x4*)(xr + 4 * lane + 256 * j); }
#pragma unroll
        for (int k = 0; k < KR; ++k) { float s_ = 0.f;
#pragma unroll
            for (int j = 0; j < 4; ++j) s_ += (v[k][j].x * v[k][j].x + v[k][j].y * v[k][j].y) + (v[k][j].z * v[k][j].z + v[k][j].w * v[k][j].w);
            ss[k] = s_; }
#pragma unroll
        for (int o = 1; o < 64; o <<= 1) {
#pragma unroll
            for (int k = 0; k < KR; ++k) ss[k] += __shfl_xor(ss[k], o); }
#pragma unroll
        for (int k = 0; k < KR; ++k) {
            const int row = row0 + k * NGW;
            if (row >= T) break;
            const float rms = rsqrtf(ss[k] * (1.f / 1024.f) + EPS);
            if (which < 2) {
                const int mi = row < TC ? 0 : 1 + ((row - TC) >> 11);
                const float* md = (const float*)(ws + CTL_MOD) + (size_t)(l * 3 + mi) * 6144;
                const float* shp = md + (which == 0 ? 0 : 3072); const float* scp = md + (which == 0 ? 1024 : 4096);
                bf16_t* o = (bf16_t*)(ws + WS_H) + (size_t)row * 1024;
#pragma unroll
                for (int j = 0; j < 4; ++j) { const int c = 4 * lane + 256 * j; const f32x4 g = *(const f32x4*)(gg + c), sc = *(const f32x4*)(scp + c), sh = *(const f32x4*)(shp + c);
                    const f32x4 y = v[k][j] * rms * g * (sc + 1.f) + sh;
                    u32x2 w; w.x = cvtpk(y.x, y.y); w.y = cvtpk(y.z, y.w); *(u32x2*)(o + c) = w; }
            } else {
                float* o = p.out + (size_t)row * 1024;
#pragma unroll
                for (int j = 0; j < 4; ++j) { const int c = 4 * lane + 256 * j; const f32x4 g = *(const f32x4*)(gg + c); *(f32x4*)(o + c) = v[k][j] * rms * g; }
            }
        }
    }
}

template <int N> DI void load_bf(const bf16_t* src, float* v) {
#pragma unroll
    for (int j = 0; j < N / 8; ++j) unpack8(*(const u32x4*)(src + 8 * j), v + 8 * j);
}
template <int N> DI void load_f32(const float* src, float* v) {
#pragma unroll
    for (int j = 0; j < N / 4; ++j) { const f32x4 w = *(const f32x4*)(src + 4 * j); v[4 * j] = w[0]; v[4 * j + 1] = w[1]; v[4 * j + 2] = w[2]; v[4 * j + 3] = w[3]; }
}
template <int N> DI void store_bf(bf16_t* dst, const float* v) {
#pragma unroll
    for (int j = 0; j < N / 8; ++j) *(u32x4*)(dst + 8 * j) = pack8(v + 8 * j);
}
template <int N> DI void store_f32(float* dst, const float* v) {
#pragma unroll
    for (int j = 0; j < N / 4; ++j) *(f32x4*)(dst + 4 * j) = (f32x4){v[4 * j], v[4 * j + 1], v[4 * j + 2], v[4 * j + 3]};
}
template <int N> DI void store_tr(bf16_t* dst, size_t stride, const float* v) {
#pragma unroll
    for (int d = 0; d < N; d += 2) { const unsigned w = cvtpk(v[d], v[d + 1]); dst[(size_t)d * stride] = (bf16_t)(w & 0xffffu); dst[(size_t)(d + 1) * stride] = (bf16_t)(w >> 16); }
}
template <int N> DI void store_kfrag(bf16_t* base, int key, const float* v) {
    const int tile = key >> 5, r = key & 31;
#pragma unroll
    for (int s = 0; s < N / 16; ++s)
#pragma unroll
        for (int h = 0; h < 2; ++h) *(u32x4*)(base + ((size_t)((tile * (N / 16) + s) * 64 + h * 32 + r)) * 8) = pack8(v + 16 * s + 8 * h);
}
DI void store_vfrag(bf16_t* base, int key, const float* v) {
    const int tile = key >> 5, sp = (key >> 4) & 1, kk = key & 15, h = (kk >> 2) & 1, j = ((kk >> 3) << 2) | (kk & 3);
    bf16_t* b0 = base + ((size_t)(tile * 4 + sp) * 64 + h * 32) * 8 + j;
#pragma unroll
    for (int d = 0; d < 64; d += 2) { const unsigned w = cvtpk(v[d], v[d + 1]);
        b0[(size_t)((d >> 5) * 2 * 64 + (d & 31)) * 8] = (bf16_t)(w & 0xffffu); b0[(size_t)((d >> 5) * 2 * 64 + ((d + 1) & 31)) * 8] = (bf16_t)(w >> 16); }
}
template <int N> DI void rms_scale(float* v, const float* g) {
    float ss = 0.f;
#pragma unroll
    for (int d = 0; d < N; ++d) ss += v[d] * v[d];
    const float r = rsqrtf(ss * (1.f / N) + EPS);
#pragma unroll
    for (int d = 0; d < N; ++d) v[d] = v[d] * r * g[d];
}
template <int N> DI void rope(float* v, int pos) {
#pragma unroll
    for (int i0 = 0; i0 < N / 2; i0 += 8) {
        const int pk = opaque_v(pos);
        const float frow = (float)(pk >> 6), fcol = (float)(pk & 63);
#pragma unroll
        for (int i = i0; i < i0 + 8; ++i) {
            const int q = i % (N / 4);
            const float inv = exp2f(-(float)q * (13.287712379549449f / (float)(N / 4)));
            const float ang = (i < N / 4 ? frow : fcol) * inv;
            const float c = __cosf(ang), s = __sinf(ang);
            const float x1 = v[i], x2 = v[i + N / 2];
            v[i] = x1 * c - x2 * s; v[i + N / 2] = x1 * s + x2 * c;
        }
    }
}

DI void pp_phase(const Params& p, int l) {
    const int tid_ = opaque_v(TIDX), lane = tid_ & 63, wave = __builtin_amdgcn_readfirstlane(tid_ >> 6), gw = blockIdx.x * NWAVES + wave, NGW = gridDim.x * NWAVES;
    unsigned char* ws = p.ws;
    const bf16_t* proj = (const bf16_t*)(ws + WS_PROJ);
    unsigned char* att = ws + WS_ATT;
    constexpr int NT_ITEMS = 192 * 29, NC_ITEMS = 16 * 16;
    for (int it = gw; it < NT_ITEMS + NC_ITEMS; it += NGW) {
        if (it < NT_ITEMS) {
            const int tile = it / 29, task = it % 29, t = tile * 64 + lane;
            const bool ctx = t < TC;
            const int b = ctx ? (t >> 8) : ((t - TC) >> 11), s = ctx ? (t & 255) : ((t - TC) & 2047);
            const bf16_t* prow = proj + (size_t)t * NPROJ;
            if (task < 4) {
                float v[64]; load_bf<64>(prow + task * 64, v);
                rms_scale<64>(v, p.in[14] + l * 64);
                if (!ctx) rope<64>(v, s);
                store_bf<64>((bf16_t*)(att + A_QB) + (size_t)t * 256 + task * 64, v);
            } else if (task < 6) {
                const int hk = task - 4;
                float v[64]; load_bf<64>(prow + 256 + hk * 64, v);
                rms_scale<64>(v, p.in[15] + l * 64);
                if (ctx) { store_f32<64>(p.out + O_GK + ((size_t)((b * 4 + l) * 256 + s) * 2 + hk) * 64, v);
                           store_kfrag<64>((bf16_t*)(att + A_KBC) + (size_t)(b * 2 + hk) * 256 * 64, s, v); }
                else { rope<64>(v, s); store_kfrag<64>((bf16_t*)(att + A_KBL) + (size_t)(b * 2 + hk) * 2560 * 64, 512 + s, v); }
            } else if (task < 8) {
                const int hk = task - 6;
                float v[64]; load_bf<64>(prow + 384 + hk * 64, v);
                if (ctx) { store_f32<64>(p.out + O_GV + ((size_t)((b * 4 + l) * 256 + s) * 2 + hk) * 64, v);
                           store_vfrag((bf16_t*)(att + A_VBC) + (size_t)(b * 2 + hk) * 64 * 256, s, v); }
                else store_vfrag((bf16_t*)(att + A_VBL) + (size_t)(b * 2 + hk) * 64 * 2560, 512 + s, v);
            } else if (task < 16) {
                const int hm = task - 8;
                if (!ctx) {
                    float v[32]; load_bf<32>(prow + 512 + hm * 32, v);
                    rope<32>(v, s);
                    store_bf<32>((bf16_t*)(att + A_QC) + (size_t)t * 256 + hm * 32, v);
                }
            } else if (task < 24) {
                const int hm = task - 16;
                float v[32]; load_bf<32>(prow + 768 + hm * 32, v);
                if (ctx) { store_f32<32>(p.out + O_DK + ((size_t)((b * 4 + l) * 256 + s) * 8 + hm) * 32, v);
                           store_kfrag<32>((bf16_t*)(att + A_KCC) + (size_t)(b * 8 + hm) * 256 * 32, s, v); }
                else { rope<32>(v, s); store_kfrag<32>((bf16_t*)(att + A_KCL) + (size_t)(b * 8 + hm) * 2560 * 32, 512 + s, v); }
            } else if (task < 28) {
                const int h = task - 24;
                float v[64]; load_bf<64>(prow + 1024 + h * 64, v);
                if (ctx) { store_f32<64>(p.out + O_DV + ((size_t)((b * 4 + l) * 256 + s) * 4 + h) * 64, v);
                           store_vfrag((bf16_t*)(att + A_VCC) + (size_t)(b * 4 + h) * 64 * 256, s, v); }
                else store_vfrag((bf16_t*)(att + A_VCL) + (size_t)(b * 4 + h) * 64 * 2560, 512 + s, v);
            } else {
                float ss = 0.f;
#pragma unroll 1
                for (int jb = 0; jb < 32; jb += 8) {
                    u32x4 rw[8];
#pragma unroll
                    for (int j = 0; j < 8; ++j) rw[j] = *(const u32x4*)(prow + 1536 + 8 * (jb + j));
#pragma unroll
                    for (int j = 0; j < 8; ++j) { float v[8]; unpack8(rw[j], v);
#pragma unroll
                        for (int e = 0; e < 8; ++e) ss += v[e] * v[e]; }
                }
                const float r = rsqrtf(ss * (1.f / 256.f) + EPS);
                const int chunk = t >> 7, pp = t & 127;
                const float* sg = p.in[21] + l * 256;
                bf16_t* dvt = (bf16_t*)(ws + WS_DVT);
#pragma unroll 1
                for (int jb = 0; jb < 32; jb += 8) {
                    u32x4 rw[8];
#pragma unroll
                    for (int j = 0; j < 8; ++j) rw[j] = *(const u32x4*)(prow + 1536 + 8 * (jb + j));
                    const int g = jb >> 3;
                    bf16_t* d0 = dvt + ((size_t)((g >> 1) * 6144 + chunk * 64) * 256 + (g & 1) * 128 + pp);
#pragma unroll
                    for (int j = 0; j < 8; ++j) { float v[8]; unpack8(rw[j], v);
                        const f32x4 s0 = *(const f32x4*)(sg + 8 * (jb + j)), s1 = *(const f32x4*)(sg + 8 * (jb + j) + 4);
                        const float sv[8] = {s0.x, s0.y, s0.z, s0.w, s1.x, s1.y, s1.z, s1.w};
#pragma unroll
                        for (int e = 0; e < 8; e += 2) { const int c = 8 * j + e;
                            const unsigned w = cvtpk(v[e] * r * sv[e], v[e + 1] * r * sv[e + 1]);
                            d0[(size_t)c * 256] = (bf16_t)(w & 0xffffu); d0[(size_t)(c + 1) * 256] = (bf16_t)(w >> 16); } }
                }
            }
        } else {
            const int ci = it - NT_ITEMS, tile = ci / 16, task = ci % 16, ct = tile * 64 + lane, b = ct >> 9, pos = ct & 511;
            const size_t crow = (size_t)(b * 4 + l) * 512 + pos;
            if (task < 2) { float v[64]; load_f32<64>(p.in[3] + (crow * 2 + task) * 64, v); store_kfrag<64>((bf16_t*)(att + A_KBL) + (size_t)(b * 2 + task) * 2560 * 64, pos, v); }
            else if (task < 4) { const int hk = task - 2; float v[64]; load_f32<64>(p.in[4] + (crow * 2 + hk) * 64, v); store_vfrag((bf16_t*)(att + A_VBL) + (size_t)(b * 2 + hk) * 64 * 2560, pos, v); }
            else if (task < 12) { const int hm = task - 4; float v[32]; load_f32<32>(p.in[5] + (crow * 8 + hm) * 32, v); store_kfrag<32>((bf16_t*)(att + A_KCL) + (size_t)(b * 8 + hm) * 2560 * 32, pos, v); }
            else { const int h = task - 12; float v[64]; load_f32<64>(p.in[6] + (crow * 4 + h) * 64, v); store_vfrag((bf16_t*)(att + A_VCL) + (size_t)(b * 4 + h) * 64 * 2560, pos, v); }
        }
    }
}

#define MFMA32(a, b, c) __builtin_amdgcn_mfma_f32_32x32x16_bf16((a), (b), (c), 0, 0, 0)
template <int DQK, int NMAP>
DI void attn_core(const bf16_t* Q, int ldq, const bf16_t* K, size_t kmapstride, const bf16_t* VT, int kb, int ke, float cs, f32x16 (&o)[NMAP][2], float (&mrun)[NMAP], float (&lrun)[NMAP], int lane) {
    constexpr int NS = DQK / 16;
    const int r = lane & 31, h = lane >> 5;
    bf16x8 qf[NMAP][NS];
#pragma unroll
    for (int mp = 0; mp < NMAP; ++mp)
#pragma unroll
        for (int s = 0; s < NS; ++s) qf[mp][s] = *(const bf16x8*)(Q + (size_t)r * ldq + mp * 32 + 16 * s + 8 * h);
#pragma unroll
    for (int mp = 0; mp < NMAP; ++mp) { mrun[mp] = -1e30f; lrun[mp] = 0.f;
#pragma unroll
        for (int i = 0; i < 16; ++i) { o[mp][0][i] = 0.f; o[mp][1][i] = 0.f; } }
    const unsigned lo16 = (unsigned)lane * 16u;
    bf16x8 Ka[NMAP][NS], Kb[NMAP][NS], Va[2][2], Vb[2][2];
    f32x16 Sx, Sy;
    bf16x8 P0a, P0b, P1a, P1b;
#define AT_LOADK(Kx, tile) do { _Pragma("unroll") for (int mp_ = 0; mp_ < NMAP; ++mp_) _Pragma("unroll") for (int s_ = 0; s_ < NS; ++s_) \
        Kx[mp_][s_] = *(const bf16x8*)((const char*)K + ((size_t)mp_ * kmapstride + (size_t)((tile) * NS + s_) * 512) * 2 + lo16); } while (0)
#define AT_LOADV(Vx, tile) do { _Pragma("unroll") for (int mt_ = 0; mt_ < 2; ++mt_) _Pragma("unroll") for (int sp_ = 0; sp_ < 2; ++sp_) \
        Vx[mt_][sp_] = *(const bf16x8*)((const char*)VT + (size_t)(((tile) * 2 + mt_) * 2 + sp_) * 1024 + lo16); } while (0)
#define AT_QK(Sd, Kx, mp) do { _Pragma("unroll") for (int i_ = 0; i_ < 16; ++i_) Sd[i_] = 0.f; _Pragma("unroll") for (int s_ = 0; s_ < NS; ++s_) Sd = MFMA32(Kx[mp][s_], qf[mp][s_], Sd); } while (0)
#define AT_PV(Pa_, Pb_, Vx, mp) do { _Pragma("unroll") for (int mt_ = 0; mt_ < 2; ++mt_) { o[mp][mt_] = MFMA32(Vx[mt_][0], Pa_, o[mp][mt_]); o[mp][mt_] = MFMA32(Vx[mt_][1], Pb_, o[mp][mt_]); } } while (0)
#define AT_SOFTMAX(S, mp, Pa_, Pb_) do { \
        float mx = fmaxf(fmaxf(S[0], S[1]), fmaxf(S[2], S[3])); \
        _Pragma("unroll") for (int i = 4; i < 16; i += 4) mx = fmaxf(mx, fmaxf(fmaxf(S[i], S[i + 1]), fmaxf(S[i + 2], S[i + 3]))); \
        { const auto sw_ = __builtin_amdgcn_permlane32_swap(__builtin_bit_cast(unsigned, mx), __builtin_bit_cast(unsigned, mx), false, false); \
          mx = fmaxf(__builtin_bit_cast(float, sw_[0]), __builtin_bit_cast(float, sw_[1])); } \
        if (__builtin_amdgcn_ballot_w64(mx > mrun[mp]) != 0ull) { \
            const float mn = fmaxf(mrun[mp], mx); \
            const float alpha = __builtin_amdgcn_exp2f((mrun[mp] - mn) * cs); \
            mrun[mp] = mn; lrun[mp] *= alpha; \
            o[mp][0] *= alpha; o[mp][1] *= alpha; \
        } \
        const float nb = mrun[mp] * cs; \
        float ps = 0.f; \
        { float pv[8]; _Pragma("unroll") for (int i = 0; i < 8; ++i) { pv[i] = __builtin_amdgcn_exp2f(S[i] * cs - nb); ps += pv[i]; } Pa_ = __builtin_bit_cast(bf16x8, pack8(pv)); } \
        { float pv[8]; _Pragma("unroll") for (int i = 0; i < 8; ++i) { pv[i] = __builtin_amdgcn_exp2f(S[8 + i] * cs - nb); ps += pv[i]; } Pb_ = __builtin_bit_cast(bf16x8, pack8(pv)); } \
        lrun[mp] += ps; \
    } while (0)
    const int t0 = kb >> 5, t1 = ke >> 5, tl = t1 - 1;
#define AT_CL(t) ((t) < tl ? (t) : tl)
    AT_LOADK(Ka, t0); AT_LOADV(Va, t0); AT_LOADK(Kb, t0 + 1); AT_LOADV(Vb, t0);
    AT_QK(Sx, Ka, 0);
    { const bf16x8 z = {0, 0, 0, 0, 0, 0, 0, 0}; P0a = z; P0b = z; P1a = z; P1b = z; }
    if constexpr (NMAP == 1) {
        AT_LOADK(Ka, AT_CL(t0 + 2));
        for (int t = t0; t < t1; t += 2) {
            AT_QK(Sy, Kb, 0); AT_LOADK(Kb, AT_CL(t + 3));
            AT_PV(P1a, P1b, Vb, 0); AT_LOADV(Vb, t + 1);
            AT_SOFTMAX(Sx, 0, P0a, P0b);
            AT_QK(Sx, Ka, 0); AT_LOADK(Ka, AT_CL(t + 4));
            AT_PV(P0a, P0b, Va, 0); AT_LOADV(Va, AT_CL(t + 2));
            AT_SOFTMAX(Sy, 0, P1a, P1b);
        }
        AT_PV(P1a, P1b, Vb, 0);
    } else {
        for (int t = t0; t < t1; t += 2) {
            AT_QK(Sy, Ka, 1); AT_LOADK(Ka, AT_CL(t + 2));
            AT_PV(P0a, P0b, Va, 0); AT_PV(P1a, P1b, Va, 1); AT_LOADV(Va, t);
            AT_SOFTMAX(Sx, 0, P0a, P0b);
            AT_QK(Sx, Kb, 0);
            AT_SOFTMAX(Sy, 1, P1a, P1b);
            AT_QK(Sy, Kb, 1); AT_LOADK(Kb, AT_CL(t + 3));
            AT_PV(P0a, P0b, Va, 0); AT_PV(P1a, P1b, Va, 1); AT_LOADV(Va, t + 1);
            AT_SOFTMAX(Sx, 0, P0a, P0b);
            AT_QK(Sx, Ka, 0);
            AT_SOFTMAX(Sy, 1, P1a, P1b);
        }
        AT_PV(P0a, P0b, Va, 0); AT_PV(P1a, P1b, Va, 1);
    }
#undef AT_LOADK
#undef AT_LOADV
#undef AT_QK
#undef AT_PV
#undef AT_SOFTMAX
#undef AT_CL
}

template <int DQK, int NMAP>
DI void attn_core_staged(const bf16_t* Q, const bf16_t* K, size_t kmapstride, const bf16_t* VT, int half, int ntile, float cs, f32x16 (&o)[NMAP][2], float (&mrun)[NMAP], float (&lrun)[NMAP],
                         int lane, int wave, LAS unsigned char* ring) {
    constexpr int NS = DQK / 16;
    const int r = lane & 31, h = lane >> 5;
    bf16x8 qf[NMAP][NS];
#pragma unroll
    for (int mp = 0; mp < NMAP; ++mp)
#pragma unroll
        for (int s = 0; s < NS; ++s) qf[mp][s] = *(const bf16x8*)(Q + (size_t)r * 256 + mp * 32 + 16 * s + 8 * h);
#pragma unroll
    for (int mp = 0; mp < NMAP; ++mp) { mrun[mp] = -1e30f; lrun[mp] = 0.f;
#pragma unroll
        for (int i = 0; i < 16; ++i) { o[mp][0][i] = 0.f; o[mp][1][i] = 0.f; } }
    const char* src[2]; size_t tstride[2];
#pragma unroll
    for (int j = 0; j < 2; ++j) { const int pc = 2 * wave + j, hh = pc >> 3, q = pc & 7;
        if (q < 4) { const int mp = NMAP == 1 ? 0 : (q >> 1), sx = NMAP == 1 ? q : (q & 1);
            src[j] = (const char*)K + ((size_t)mp * kmapstride + (size_t)((hh * ntile) * NS + sx) * 512) * 2 + lane * 16; tstride[j] = (size_t)NS * 1024; }
        else { src[j] = (const char*)VT + (size_t)(((hh * ntile) * 2 + ((q - 4) >> 1)) * 2 + ((q - 4) & 1)) * 1024 + lane * 16; tstride[j] = 4096; } }
#define AS_ISSUE(t) do { _Pragma("unroll") for (int j_ = 0; j_ < 2; ++j_) \
        __builtin_amdgcn_global_load_lds((const unsigned*)(src[j_] + (size_t)(t) * tstride[j_]), (LAS unsigned*)(ring + ((t) & 3) * 16384 + (2 * wave + j_) * 1024), 16, 0, 0); } while (0)
    asm volatile("s_waitcnt vmcnt(0)" ::: "memory");
    AS_ISSUE(0); AS_ISSUE(1); AS_ISSUE(2);
    for (int t = 0; t < ntile; ++t) {
        asm volatile("s_waitcnt vmcnt(4)" ::: "memory");
        __builtin_amdgcn_s_barrier();
        AS_ISSUE(t + 3);
        const LAS unsigned char* sl = ring + (t & 3) * 16384 + half * 8192 + lane * 16;
        bf16x8 kf[NMAP][NS], vf[2][2];
#pragma unroll
        for (int mp = 0; mp < NMAP; ++mp)
#pragma unroll
            for (int s = 0; s < NS; ++s) kf[mp][s] = *(const LAS bf16x8*)(sl + (mp * NS + s) * 1024);
#pragma unroll
        for (int mt = 0; mt < 2; ++mt)
#pragma unroll
            for (int sp = 0; sp < 2; ++sp) vf[mt][sp] = *(const LAS bf16x8*)(sl + 4096 + (mt * 2 + sp) * 1024);
#pragma unroll
        for (int mp = 0; mp < NMAP; ++mp) {
            f32x16 S;
#pragma unroll
            for (int i = 0; i < 16; ++i) S[i] = 0.f;
#pragma unroll
            for (int s = 0; s < NS; ++s) S = MFMA32(kf[mp][s], qf[mp][s], S);
            float mx = fmaxf(fmaxf(S[0], S[1]), fmaxf(S[2], S[3]));
#pragma unroll
            for (int i = 4; i < 16; i += 4) mx = fmaxf(mx, fmaxf(fmaxf(S[i], S[i + 1]), fmaxf(S[i + 2], S[i + 3])));
            { const auto sw_ = __builtin_amdgcn_permlane32_swap(__builtin_bit_cast(unsigned, mx), __builtin_bit_cast(unsigned, mx), false, false);
              mx = fmaxf(__builtin_bit_cast(float, sw_[0]), __builtin_bit_cast(float, sw_[1])); }
            if (__builtin_amdgcn_ballot_w64(mx > mrun[mp]) != 0ull) {
                const float mn = fmaxf(mrun[mp], mx);
                const float alpha = __builtin_amdgcn_exp2f((mrun[mp] - mn) * cs);
                mrun[mp] = mn; lrun[mp] *= alpha;
                o[mp][0] *= alpha; o[mp][1] *= alpha;
            }
            const float nb = mrun[mp] * cs;
            float ps = 0.f; bf16x8 pa, pb;
            { float pv[8];
#pragma unroll
              for (int i = 0; i < 8; ++i) { pv[i] = __builtin_amdgcn_exp2f(S[i] * cs - nb); ps += pv[i]; } pa = __builtin_bit_cast(bf16x8, pack8(pv)); }
            { float pv[8];
#pragma unroll
              for (int i = 0; i < 8; ++i) { pv[i] = __builtin_amdgcn_exp2f(S[8 + i] * cs - nb); ps += pv[i]; } pb = __builtin_bit_cast(bf16x8, pack8(pv)); }
            lrun[mp] += ps;
#pragma unroll
            for (int mt = 0; mt < 2; ++mt) { o[mp][mt] = MFMA32(vf[mt][0], pa, o[mp][mt]); o[mp][mt] = MFMA32(vf[mt][1], pb, o[mp][mt]); }
        }
    }
    asm volatile("s_waitcnt vmcnt(0)" ::: "memory");
    __builtin_amdgcn_s_barrier();
#undef AS_ISSUE
}

template <int TYPE>
DI void attn_item(const Params& p, int l, int lat, int b, int head, int qt, int part, int nparts, LAS float* xch, bool combine, int lane, int wave, LAS unsigned char* lds) {
    constexpr int NMAP = TYPE == 0 ? 1 : 2;
    constexpr int DQK = TYPE == 0 ? 64 : 32;
    unsigned char* ws = p.ws;
    unsigned char* att = ws + WS_ATT;
    bf16_t* br = (bf16_t*)(ws + WS_BR);
    const int r = lane & 31, h = lane >> 5;
    const int token0 = (lat ? TC + b * 2048 : b * 256) + qt * 32;
    const int nkeys = lat ? 2560 : 256;
    const int kb = part * (nkeys / nparts), ke = kb + nkeys / nparts;
    const bf16_t *Q, *K, *VT; size_t kms = 0; float cs; int ldq = 256;
    if (TYPE == 0) {
        const int hk = head >> 1;
        Q = (const bf16_t*)(att + A_QB) + (size_t)token0 * 256 + head * 64;
        K = lat ? (const bf16_t*)(att + A_KBL) + (size_t)(b * 2 + hk) * 2560 * 64 : (const bf16_t*)(att + A_KBC) + (size_t)(b * 2 + hk) * 256 * 64;
        VT = lat ? (const bf16_t*)(att + A_VBL) + (size_t)(b * 2 + hk) * 64 * 2560 : (const bf16_t*)(att + A_VBC) + (size_t)(b * 2 + hk) * 64 * 256;
        cs = 0.125f * 1.4426950408889634f;
    } else {
        if (lat) Q = (const bf16_t*)(att + A_QC) + (size_t)token0 * 256 + head * 64;
        else { Q = (const bf16_t*)(ws + WS_PROJ) + (size_t)token0 * NPROJ + 512 + head * 64; ldq = NPROJ; }
        K = lat ? (const bf16_t*)(att + A_KCL) + (size_t)(b * 8 + head * 2) * 2560 * 32 : (const bf16_t*)(att + A_KCC) + (size_t)(b * 8 + head * 2) * 256 * 32;
        VT = lat ? (const bf16_t*)(att + A_VCL) + (size_t)(b * 4 + head) * 64 * 2560 : (const bf16_t*)(att + A_VCC) + (size_t)(b * 4 + head) * 64 * 256;
        kms = (size_t)nkeys * 32; cs = 0.17677669529663687f * 1.4426950408889634f;
    }
    f32x16 o[NMAP][2]; float mr[NMAP], lr[NMAP];
    if (combine) attn_core_staged<DQK, NMAP>(Q, K, kms, VT, part, nkeys / (32 * nparts), cs, o, mr, lr, lane, wave, lds);
    else attn_core<DQK, NMAP>(Q, ldq, K, kms, VT, kb, ke, cs, o, mr, lr, lane);
    if (combine) {
        if (part == 1) {
#pragma unroll
            for (int mp = 0; mp < NMAP; ++mp) {
#pragma unroll
                for (int mt = 0; mt < 2; ++mt)
#pragma unroll
                    for (int i = 0; i < 16; ++i) xch[((mp * 2 + mt) * 16 + i) * 64 + lane] = o[mp][mt][i];
                xch[(64 + mp * 2) * 64 + lane] = mr[mp]; xch[(65 + mp * 2) * 64 + lane] = lr[mp];
            }
        }
        __syncthreads();
        if (part == 1) return;
#pragma unroll
        for (int mp = 0; mp < NMAP; ++mp) {
            const float m2 = xch[(64 + mp * 2) * 64 + lane], l2 = xch[(65 + mp * 2) * 64 + lane];
            const float mn = fmaxf(mr[mp], m2), a1 = __builtin_amdgcn_exp2f((mr[mp] - mn) * cs), a2 = __builtin_amdgcn_exp2f((m2 - mn) * cs);
            lr[mp] = lr[mp] * a1 + l2 * a2;
#pragma unroll
            for (int mt = 0; mt < 2; ++mt)
#pragma unroll
                for (int i = 0; i < 16; ++i) o[mp][mt][i] = o[mp][mt][i] * a1 + xch[((mp * 2 + mt) * 16 + i) * 64 + lane] * a2;
        }
    }
    float ls[NMAP];
#pragma unroll
    for (int mp = 0; mp < NMAP; ++mp) ls[mp] = lr[mp] + __shfl_xor(lr[mp], 32);
    if (TYPE == 0) {
        const float inv = 1.f / ls[0];
        bf16_t* dst = br + (size_t)(token0 + r) * 1280 + 512 + head * 64;
#pragma unroll
        for (int mt = 0; mt < 2; ++mt)
#pragma unroll
            for (int g4 = 0; g4 < 4; ++g4) { u32x2 w; w.x = cvtpk(o[0][mt][4 * g4] * inv, o[0][mt][4 * g4 + 1] * inv); w.y = cvtpk(o[0][mt][4 * g4 + 2] * inv, o[0][mt][4 * g4 + 3] * inv);
                *(u32x2*)(dst + 32 * mt + 8 * g4 + 4 * h) = w; }
    } else {
        const float lam = ((const float*)(ws + CTL_LAM))[l];
        const float lam_scale = 1.f - (0.8f - 0.6f * expf(-0.3f * (float)l));
        const float i0 = 1.f / ls[0], i1 = lam / ls[NMAP - 1];
        float ss = 0.f;
#pragma unroll
        for (int mt = 0; mt < 2; ++mt)
#pragma unroll
            for (int i = 0; i < 16; ++i) { const float v = o[0][mt][i] * i0 - o[NMAP - 1][mt][i] * i1; o[0][mt][i] = v; ss += v * v; }
        ss += __shfl_xor(ss, 32);
        const float rn = rsqrtf(ss * (1.f / 64.f) + EPS) * lam_scale;
        const float* dg = p.in[20] + l * 64;
        bf16_t* dst = br + (size_t)(token0 + r) * 1280 + 768 + head * 64;
#pragma unroll
        for (int mt = 0; mt < 2; ++mt)
#pragma unroll
            for (int g4 = 0; g4 < 4; ++g4) { const int d0 = 32 * mt + 8 * g4 + 4 * h; const f32x4 g = *(const f32x4*)(dg + d0);
                u32x2 w; w.x = cvtpk(o[0][mt][4 * g4] * rn * g[0], o[0][mt][4 * g4 + 1] * rn * g[1]); w.y = cvtpk(o[0][mt][4 * g4 + 2] * rn * g[2], o[0][mt][4 * g4 + 3] * rn * g[3]);
                *(u32x2*)(dst + d0) = w; }
    }
}

DI void attn_phase(const Params& p, int l, LAS unsigned char* lds) {
    const int tid_ = opaque_v(TIDX), lane = tid_ & 63, wave = __builtin_amdgcn_readfirstlane(tid_ >> 6);
    const int bx = blockIdx.x;
    const int bb = bx - 32;
    LAS float* xch = (LAS float*)lds + (wave & 3) * (68 * 64);
    { int n0 = -1, nstep = 0, ncnt = 0;
      if (bx < 32) { n0 = bx * 8 + wave; nstep = 256; ncnt = 2; }
      else if (bb >= 160) { n0 = 512 + (bb - 160) * 8 + wave; nstep = 512; ncnt = 3; }
      if (bx < 32) {
        for (int j = 0; j < ncnt; ++j) { const int n = n0 + j * nstep, i2 = n;
            const int type = i2 >> 10, rem = i2 & 1023, b = rem >> 5, head = (rem >> 3) & 3, qt = rem & 7;
            if (type == 0) attn_item<0>(p, l, 0, b, head, qt, 0, 1, xch, false, lane, wave, lds);
            else attn_item<1>(p, l, 0, b, head, qt, 0, 1, xch, false, lane, wave, lds); }
        return;
      }
    }
    for (int round = 0; round < 2; ++round) {
        if (round == 1 && (bb < 128 || bb >= 160)) break;
        const int q = bb * 4 + (wave & 3);
        int type, ii;
        if (round == 0) { type = q < 512 ? 1 : 0; ii = q < 512 ? q : q - 512; }
        else { type = 0; ii = 384 + (bb - 128) * 4 + (wave & 3); }
        const int b = ii >> 8, head = (ii >> 6) & 3, qt = ii & 63;
        if (type == 0) attn_item<0>(p, l, 1, b, head, qt, wave >> 2, 2, xch, true, lane, wave, lds);
        else attn_item<1>(p, l, 1, b, head, qt, wave >> 2, 2, xch, true, lane, wave, lds);
        __syncthreads();
    }
    if (bb >= 160)
    for (int j = 0; j < 3; ++j) { const int n = 512 + (bb - 160) * 8 + wave + j * 512, i2 = n;
        const int type = i2 >> 10, rem = i2 & 1023, b = rem >> 5, head = (rem >> 3) & 3, qt = rem & 7;
        if (type == 0) attn_item<0>(p, l, 0, b, head, qt, 0, 1, xch, false, lane, wave, lds);
        else attn_item<1>(p, l, 0, b, head, qt, 0, 1, xch, false, lane, wave, lds);
    }
}

#define XB_TMO      128
#define XB_XCNT(j)  (256  + 64 * (j))
#define XB_XSUB(j)  (1280 + 64 * (j))
#define XB_XGEN(j)  (2304 + 64 * (j))
#define XB_TOP      3328
#define XB_TOPGEN   3392
#define XCD_BAR_WORDS 3456
#define XB_SPIN_CAP (1u << 20)
DI unsigned xb_ld(unsigned* p)              { return __hip_atomic_load(p, __ATOMIC_RELAXED, __HIP_MEMORY_SCOPE_AGENT); }
DI unsigned xb_add(unsigned* p, unsigned v) { return __hip_atomic_fetch_add(p, v, __ATOMIC_RELAXED, __HIP_MEMORY_SCOPE_AGENT); }
DI unsigned xb_xcc_id() { return (unsigned)__builtin_amdgcn_s_getreg((3 << 11) | 20) & 0xFu; }
#define XB_SPIN(cond, bar) do { unsigned _sp = 0; while (cond) { __builtin_amdgcn_s_sleep(1); \
    if ((++_sp & 255u) == 0u) { if (xb_ld(&(bar)[XB_TMO])) break; if (_sp > XB_SPIN_CAP) { atomicAdd(&(bar)[XB_TMO], 1u); break; } } } } while (0)
struct XcdBarrier { unsigned* bar; unsigned x; volatile LAS unsigned* st; };
DI XcdBarrier xcd_barrier_post(unsigned* bar, volatile LAS unsigned* st) {
    XcdBarrier b; b.bar = bar; b.x = xb_xcc_id(); b.st = st;
    if (TIDX == 0) (void)xb_add(&bar[XB_XCNT(b.x)], 1u);
    return b;
}
DI void xcd_barrier_complete(unsigned* bar, unsigned x, unsigned& nloc, unsigned& nx) {
    const unsigned G = gridDim.x * gridDim.y * gridDim.z;
    unsigned sum, cnt, mine, sp = 0u;
    for (;;) {
        sum = 0u; cnt = 0u; mine = 0u;
#pragma unroll
        for (unsigned j = 0; j < 16; ++j) { const unsigned c = xb_ld(&bar[XB_XCNT(j)]); sum += c; cnt += (c > 0u) ? 1u : 0u; mine = (j == x) ? c : mine; }
        if (sum == G) break;
        __builtin_amdgcn_s_sleep(1);
        if ((++sp & 255u) == 0u) { if (xb_ld(&bar[XB_TMO])) break; if (sp > XB_SPIN_CAP) { atomicAdd(&bar[XB_TMO], 1u); break; } }
    }
    nloc = mine > 0u ? mine : 1u; nx = cnt > 0u ? cnt : 1u;
}
DI void xcd_barrier(const XcdBarrier& b) {
    asm volatile("s_waitcnt vmcnt(0)" ::: "memory");
    __syncthreads();
    if (TIDX == 0) {
        unsigned* bar = b.bar;
        __builtin_amdgcn_s_waitcnt(0);
        unsigned nloc = b.st[0], nx = b.st[1];
        if (nloc == 0u) { xcd_barrier_complete(bar, b.x, nloc, nx); b.st[0] = nloc; b.st[1] = nx; }
        const unsigned old = xb_add(&bar[XB_XSUB(b.x)], 1u);
        const unsigned gen = old / nloc;
        if (old + 1u == (gen + 1u) * nloc) {
            __builtin_amdgcn_fence(__ATOMIC_RELEASE, "agent");
            asm volatile("s_waitcnt vmcnt(0)" ::: "memory");
            const unsigned og = xb_add(&bar[XB_TOP], 1u);
            const unsigned tg = og / nx;
            if (og + 1u == (tg + 1u) * nx) xb_add(&bar[XB_TOPGEN], 1u);
            else XB_SPIN(xb_ld(&bar[XB_TOPGEN]) == tg, bar);
            __builtin_amdgcn_fence(__ATOMIC_ACQUIRE, "agent");
            xb_add(&bar[XB_XGEN(b.x)], 1u);
            asm volatile("s_waitcnt vmcnt(0)" ::: "memory");
        } else {
            XB_SPIN(xb_ld(&bar[XB_XGEN(b.x)]) == gen, bar);
            __builtin_amdgcn_fence(__ATOMIC_ACQUIRE, "agent");
            asm volatile("s_waitcnt vmcnt(0)" ::: "memory");
        }
    }
    __syncthreads();
}

__global__ void __launch_bounds__(NWAVES * 64, 2) mega_fwd(Params p) {
    extern __shared__ __attribute__((aligned(16))) unsigned char lds_raw[];
    LAS unsigned char* lds = (LAS unsigned char*)lds_raw;
    cg::grid_group grid = cg::this_grid();
    const int G = gridDim.x, bx = blockIdx.x;
    unsigned char* ws = p.ws;

    { const unsigned hw_ = (unsigned)__builtin_amdgcn_s_getreg((5 << 11) | 4) & 63u; ((volatile LAS int*)(131072 + 64))[hw_] = (int)(__builtin_amdgcn_workitem_id_x() >> 6); }
    __syncthreads();
    volatile LAS unsigned* bst = (volatile LAS unsigned*)(lds + 131072);
    if (TIDX == 0) { bst[0] = 0u; bst[1] = 0u; }
    if (bx == 0 && TIDX < 64) for (int i = TIDX; i < 8192; i += 64) ((unsigned*)(ws + CTL_BAR))[i] = 0u;
    asm volatile("s_waitcnt vmcnt(0)" ::: "memory");
    grid.sync();
    (void)xcd_barrier_post((unsigned*)(ws + CTL_BAR), bst);
#define XBAR() do { XcdBarrier xb_; xb_.bar = (unsigned*)(p.ws + CTL_BAR); xb_.x = xb_xcc_id(); xb_.st = (volatile LAS unsigned*)(lds + 131072); xcd_barrier(xb_); } while (0)
    prologue(p, lds, 0, 4, bx, G, true);
    XBAR();
    for (int st = 0; st < 36; ++st) {
        const int l = st / 9, k = st % 9;
        if (k == 0 || k == 6) norm_phase(p, l, k == 0 ? 0 : 1);
        else if (k == 2) pp_phase(p, l);
        else {
            const int j0 = k == 1 ? J_G1A : k == 3 ? J_DFTL : k == 4 ? J_G2 : k == 5 ? J_G3 : k == 7 ? J_G4 : J_G5;
            const int j1 = k == 1 ? J_G1B : k == 3 ? J_SGU : j0;
            unsigned char* wl = ws + WS_W + (size_t)l * W_LAYER;
            for (int job = j0; job <= j1; ++job) {
                Sched S; S.job = job; S.G = G; S.c = bx; S.nM = 48; S.nN = 4; S.nt = 16; S.lda = 1024; S.ldb = 1024;
                switch (job) {
                case J_G1A: S.A = (const char*)(ws + WS_H); S.B = (const char*)(wl + W_CAT); S.nN = 23; break;
                case J_G1B: S.A = (const char*)(wl + W_A); S.B = (const char*)(ws + WS_H); S.nM = 2; S.nN = 48; S.c = (bx - 80 + G) % G; break;
                case J_DFTL: S.A = (const char*)(ws + WS_FLAT); S.B = (const char*)(ws + WS_ZTL); S.lda = 4096; S.ldb = 4096; S.nM = 16; S.nN = 2; break;
                case J_DFTC: S.A = (const char*)(ws + WS_FCTX); S.B = (const char*)(ws + WS_ZTC); S.lda = 512; S.ldb = 512; S.nM = 32; S.nN = 2; S.c = (bx - 32 + G) % G; break;
                case J_SGU: S.A = (const char*)(wl + W_SP); S.B = (const char*)(ws + WS_DVT); S.lda = 256; S.ldb = 256; S.nM = 2; S.nN = 24; S.c = (bx - 96 + G) % G; break;
                case J_G2: S.A = (const char*)(ws + WS_BR); S.B = (const char*)(wl + W_BALL); S.lda = 1280; S.ldb = 1280; break;
                case J_G3: S.A = (const char*)(ws + WS_MERGED); S.B = (const char*)(wl + W_OUT); break;
                case J_G4: S.A = (const char*)(ws + WS_H); S.B = (const char*)(wl + W_1); S.nN = 16; break;
                default: S.A = (const char*)(ws + WS_GATES); S.B = (const char*)(wl + W_2); S.lda = 4096; S.ldb = 4096; S.nt = 64; break;
                }
                S.nwg = S.nM * S.nN;
                const Epi E{job, l, p};
                pg8::gemm_phase<Epi, Sched>(lds, S.lda, S.ldb, S, E);
            }
            if (k == 3) attn_phase(p, l, lds);
        }
        XBAR();
    }
    norm_phase(p, 0, 2);
}

extern "C" void kernel_launch(void* const* d_in, const int* in_sizes, int n_in, void* d_out, int out_size, void* d_ws, size_t ws_size, hipStream_t stream) {
    static int grid = 0;
    constexpr int LDS_BYTES = 131072 + 1024;
    if (grid == 0) {
        if (n_in != 30 || ws_size < WS_END) { fprintf(stderr, "kernel_launch: n_in %d ws %zu (need %zu)\n", n_in, ws_size, (size_t)WS_END); grid = -1; return; }
        int dev = 0, cus = 0, per_cu = 0;
        (void)hipGetDevice(&dev);
        (void)hipDeviceGetAttribute(&cus, hipDeviceAttributeMultiprocessorCount, dev);
        (void)hipFuncSetAttribute((const void*)mega_fwd, hipFuncAttributeMaxDynamicSharedMemorySize, LDS_BYTES);
        (void)hipOccupancyMaxActiveBlocksPerMultiprocessor(&per_cu, (const void*)mega_fwd, NWAVES * 64, LDS_BYTES);
        if (per_cu < 1) per_cu = 1;
        grid = cus;
        (void)hipGetLastError();
    }
    if (grid < 0) return;
    Params prm{};
    for (int i = 0; i < 30; ++i) prm.in[i] = (const float*)d_in[i];
    prm.out = (float*)d_out; prm.ws = (unsigned char*)d_ws;
    void* args[] = {&prm};
    hipError_t e = hipLaunchCooperativeKernel((const void*)mega_fwd, dim3(grid), dim3(NWAVES * 64), args, LDS_BYTES, stream);
    if (e != hipSuccess) fprintf(stderr, "cooperative launch failed: %s (grid %d)\n", hipGetErrorString(e), grid);
}
```
